# Optimizing an MI355X kernel written in HIP

```python
import math
import jax, jax.numpy as jnp
from jax import lax
import numpy as np

D_MODEL = 1024
BATCH = 32
SEQ = 2048
DEPTH = 1

CHUNK = 64
Q_BLOCK = 128
ROPE_THETA = 500000.0
NORM_EPS = 1e-6

A_HEADS = 8
A_HEAD_DIM = 64
IDX_HEADS = 8
IDX_DIM = 64
TOPK_KEYS = 256
B_HEADS = 4
B_QK_DIM = 64
B_V_DIM = 2 * B_QK_DIM
ROT_DIM = A_HEAD_DIM // 4
N_EXPERTS = 32
TOP_EXPERTS = 4
D_EXPERT = 1024
SWIGLU_LIMIT = 7.0
SWIGLU_ALPHA = 1.702
MOE_BLOCK = 128

SPLITS = (A_HEADS * A_HEAD_DIM,
          A_HEAD_DIM,
          A_HEAD_DIM,
          IDX_HEADS * IDX_DIM,
          IDX_DIM,
          IDX_HEADS,
          B_HEADS * 2 * B_QK_DIM,
          B_HEADS * 2 * B_QK_DIM,
          B_HEADS * B_V_DIM)
D_IN = sum(SPLITS)
SPLIT_OFFSETS = np.cumsum(SPLITS)[:-1].tolist()
D_MIX = A_HEADS * A_HEAD_DIM + B_HEADS * B_V_DIM

kernel_name = 'hybrid_dsa_diffattn_moe_block'


def rms_norm(x, g):
    x32 = x.astype(jnp.float32)
    y = x32 * lax.rsqrt(jnp.mean(x32 * x32, axis=-1, keepdims=True) + NORM_EPS)
    return (y * g.astype(jnp.float32)).astype(x.dtype)


def rope_tables(positions):
    inv_freq = ROPE_THETA ** (-jnp.arange(0, ROT_DIM, 2, dtype=jnp.float32) / ROT_DIM)
    ang = positions.astype(jnp.float32)[..., None] * inv_freq
    return jnp.cos(ang), jnp.sin(ang)


def partial_rope(x, cos, sin):
    half = ROT_DIM // 2
    c = cos[:, :, None, :]
    s = sin[:, :, None, :]
    x1 = x[..., :half].astype(jnp.float32)
    x2 = x[..., half:ROT_DIM].astype(jnp.float32)
    rot = jnp.concatenate([x1 * c - x2 * s, x2 * c + x1 * s], axis=-1).astype(x.dtype)
    return jnp.concatenate([rot, x[..., ROT_DIM:]], axis=-1)


def to_blocks(t):
    b, s = t.shape[:2]
    return jnp.moveaxis(t.reshape(b, s // Q_BLOCK, Q_BLOCK, *t.shape[2:]), 1, 0)


def from_blocks(t):
    nb, b, qb = t.shape[:3]
    return jnp.moveaxis(t, 0, 1).reshape(b, nb * qb, *t.shape[3:])


def dsa_mixer(q, k, v, qi, ki, wi, k_sel):
    s_len = q.shape[1]
    key_chunk = jnp.arange(s_len) // CHUNK
    kv = jnp.concatenate([k, v], axis=-1)

    def block(args):
        bi, qb, qib, wib = args
        q_chunk = (bi * Q_BLOCK + jnp.arange(Q_BLOCK)) // CHUNK
        admissible = key_chunk[None, :] <= q_chunk[:, None]
        rel = jax.nn.relu(jnp.einsum('bqhd,bsd->bqhs', qib, ki).astype(jnp.float32))
        score = jnp.einsum('bqhs,bqh->bqs', rel, wib.astype(jnp.float32))
        score = jnp.where(admissible[None], score, -jnp.inf)
        _, idx = lax.top_k(score, k_sel)
        valid = key_chunk[idx] <= q_chunk[None, :, None]
        kv_sel = jax.vmap(lambda kvb, ib: kvb[ib])(kv, idx)
        k_sel_, v_sel = kv_sel[..., :A_HEAD_DIM], kv_sel[..., A_HEAD_DIM:]
        logits = jnp.einsum('bqhd,bqkd->bqhk', qb, k_sel_).astype(jnp.float32) * (A_HEAD_DIM ** -0.5)
        logits = jnp.where(valid[:, :, None, :], logits, -jnp.inf)
        p = jax.nn.softmax(logits, axis=-1).astype(v.dtype)
        return jnp.einsum('bqhk,bqkd->bqhd', p, v_sel)

    nb = s_len // Q_BLOCK
    out = lax.map(block, (jnp.arange(nb), to_blocks(q), to_blocks(qi), to_blocks(wi)))
    return from_blocks(out)


def diff_mixer(q1, q2, k1, k2, v, lam, lam_init, g_subln):
    s_len = q1.shape[1]
    key_chunk = jnp.arange(s_len) // CHUNK
    scale = B_QK_DIM ** -0.5

    def block(args):
        bi, q1b, q2b = args
        q_chunk = (bi * Q_BLOCK + jnp.arange(Q_BLOCK)) // CHUNK
        mask = (key_chunk[None, :] <= q_chunk[:, None])[None, None]
        s1 = jnp.einsum('bqhd,bshd->bhqs', q1b, k1).astype(jnp.float32) * scale
        s2 = jnp.einsum('bqhd,bshd->bhqs', q2b, k2).astype(jnp.float32) * scale
        p1 = jax.nn.softmax(jnp.where(mask, s1, -jnp.inf), axis=-1)
        p2 = jax.nn.softmax(jnp.where(mask, s2, -jnp.inf), axis=-1)
        a = (p1 - lam * p2).astype(v.dtype)
        return jnp.einsum('bhqs,bshd->bqhd', a, v)

    nb = s_len // Q_BLOCK
    o = from_blocks(lax.map(block, (jnp.arange(nb), to_blocks(q1), to_blocks(q2))))
    return rms_norm(o, g_subln) * (1.0 - lam_init)


def moe(h, w_router, b_router, w_gu, b_gu, w_down, b_down):
    b, s, d = h.shape
    n = b * s
    hf = h.reshape(n, d)
    logits = (hf @ w_router + b_router).astype(jnp.float32)
    top_vals, top_idx = lax.top_k(logits, TOP_EXPERTS)
    gates = jax.nn.softmax(top_vals, axis=-1)

    nk = n * TOP_EXPERTS
    flat_e = top_idx.reshape(-1)
    flat_tok = jnp.repeat(jnp.arange(n, dtype=jnp.int32), TOP_EXPERTS)
    flat_g = gates.reshape(-1)
    order = jnp.argsort(flat_e)
    e_sorted = flat_e[order]
    tok_sorted = flat_tok[order]
    g_sorted = flat_g[order]
    counts = jnp.bincount(flat_e, length=N_EXPERTS)
    padded = ((counts + MOE_BLOCK - 1) // MOE_BLOCK) * MOE_BLOCK
    start = jnp.cumsum(counts) - counts
    pend = jnp.cumsum(padded)
    pstart = pend - padded
    dest = pstart[e_sorted] + (jnp.arange(nk) - start[e_sorted])
    n_blocks = -(-(nk + N_EXPERTS * (MOE_BLOCK - 1)) // MOE_BLOCK)
    m = n_blocks * MOE_BLOCK
    slot_tok = jnp.full((m,), n, dtype=jnp.int32).at[dest].set(tok_sorted)
    slot_g = jnp.zeros((m,), jnp.float32).at[dest].set(g_sorted)
    block_expert = jnp.minimum(
        jnp.searchsorted(pend, jnp.arange(n_blocks) * MOE_BLOCK, side='right'), N_EXPERTS - 1)
    h_pad = jnp.concatenate([hf, jnp.zeros((1, d), hf.dtype)], axis=0)

    def expert_block(args):
        tok, g, e = args
        xb = h_pad[tok]
        gu = xb @ w_gu[e] + b_gu[e]
        glu = jnp.minimum(gu[:, :D_EXPERT], SWIGLU_LIMIT)
        lin = jnp.clip(gu[:, D_EXPERT:], -SWIGLU_LIMIT, SWIGLU_LIMIT)
        act = glu * jax.nn.sigmoid(SWIGLU_ALPHA * glu) * (lin + 1.0)
        return (act @ w_down[e] + b_down[e]) * g[:, None].astype(h.dtype)

    ys = lax.map(expert_block, (slot_tok.reshape(n_blocks, MOE_BLOCK),
                                slot_g.reshape(n_blocks, MOE_BLOCK), block_expert))
    out = jax.ops.segment_sum(ys.reshape(m, d), slot_tok, num_segments=n + 1)[:n]
    return out.reshape(b, s, d).astype(h.dtype)


def setup_inputs(seed: int = 0) -> dict:
    key = jax.random.key(seed)
    ks = jax.random.split(key, 24)
    f32 = jnp.float32
    L = DEPTH
    nrm = lambda k, shape, scale: jax.random.normal(k, shape, f32) * scale
    gain = lambda k, shape: 1.0 + 0.02 * jax.random.normal(k, shape, f32)
    x = jax.random.normal(ks[0], (BATCH, SEQ, D_MODEL), f32)
    offsets = jax.random.randint(ks[1], (BATCH, 1), 0, 4096) * CHUNK
    positions = (offsets + jnp.arange(SEQ)[None, :]).astype(jnp.int32)
    return {
        'x': x,
        'positions': positions,
        'g_attn': gain(ks[2], (L, D_MODEL)),
        'w_in': nrm(ks[3], (L, D_MODEL, D_IN), D_MODEL ** -0.5),
        'g_qa': gain(ks[4], (L, A_HEAD_DIM)),
        'g_ka': gain(ks[5], (L, A_HEAD_DIM)),
        'g_idx_k': gain(ks[6], (L, IDX_DIM)),
        'lambda_q1': nrm(ks[7], (L, B_QK_DIM), 0.1),
        'lambda_k1': nrm(ks[8], (L, B_QK_DIM), 0.1),
        'lambda_q2': nrm(ks[9], (L, B_QK_DIM), 0.1),
        'lambda_k2': nrm(ks[10], (L, B_QK_DIM), 0.1),
        'g_qb': gain(ks[11], (L, B_QK_DIM)),
        'g_kb': gain(ks[12], (L, B_QK_DIM)),
        'g_subln': gain(ks[13], (L, B_V_DIM)),
        'w_o': nrm(ks[14], (L, D_MIX, D_MODEL), D_MIX ** -0.5),
        'g_ffn': gain(ks[15], (L, D_MODEL)),
        'w_router': nrm(ks[16], (L, D_MODEL, N_EXPERTS), D_MODEL ** -0.5),
        'b_router': nrm(ks[17], (L, N_EXPERTS), 0.01),
        'w_gu': nrm(ks[18], (L, N_EXPERTS, D_MODEL, 2 * D_EXPERT), D_MODEL ** -0.5),
        'b_gu': nrm(ks[19], (L, N_EXPERTS, 2 * D_EXPERT), 0.02),
        'w_down': nrm(ks[20], (L, N_EXPERTS, D_EXPERT, D_MODEL), D_EXPERT ** -0.5),
        'b_down': nrm(ks[21], (L, N_EXPERTS, D_MODEL), 0.02),
    }


def reference(x, positions, g_attn, w_in, g_qa, g_ka, g_idx_k, lambda_q1, lambda_k1,
              lambda_q2, lambda_k2, g_qb, g_kb, g_subln, w_o, g_ffn, w_router, b_router,
              w_gu, b_gu, w_down, b_down):
    b, s, _ = x.shape
    k_sel = min(TOPK_KEYS, s // 4)
    cos, sin = rope_tables(positions)
    for layer in range(DEPTH):
        lam_init = 0.8 - 0.6 * math.exp(-0.3 * layer)
        h = rms_norm(x, g_attn[layer])
        proj = h @ w_in[layer]
        aq, ak, av, iq, ik, iw, bq, bk, bv = jnp.split(proj, SPLIT_OFFSETS, axis=-1)

        aq = partial_rope(rms_norm(aq.reshape(b, s, A_HEADS, A_HEAD_DIM), g_qa[layer]), cos, sin)
        ak = partial_rope(rms_norm(ak, g_ka[layer])[:, :, None], cos, sin)[:, :, 0]
        iq = partial_rope(iq.reshape(b, s, IDX_HEADS, IDX_DIM), cos, sin)
        ik = partial_rope(rms_norm(ik, g_idx_k[layer])[:, :, None], cos, sin)[:, :, 0]
        iw = iw * ((IDX_HEADS * IDX_DIM) ** -0.5)
        y_a = dsa_mixer(aq, ak, av, iq, ik, iw, k_sel).reshape(b, s, A_HEADS * A_HEAD_DIM)

        bq = bq.reshape(b, s, B_HEADS, 2, B_QK_DIM)
        bk = bk.reshape(b, s, B_HEADS, 2, B_QK_DIM)
        q1 = partial_rope(rms_norm(bq[:, :, :, 0], g_qb[layer]), cos, sin)
        q2 = partial_rope(rms_norm(bq[:, :, :, 1], g_qb[layer]), cos, sin)
        k1 = partial_rope(rms_norm(bk[:, :, :, 0], g_kb[layer]), cos, sin)
        k2 = partial_rope(rms_norm(bk[:, :, :, 1], g_kb[layer]), cos, sin)
        bv = bv.reshape(b, s, B_HEADS, B_V_DIM)
        lam = (jnp.exp(jnp.sum(lambda_q1[layer].astype(jnp.float32) * lambda_k1[layer].astype(jnp.float32)))
               - jnp.exp(jnp.sum(lambda_q2[layer].astype(jnp.float32) * lambda_k2[layer].astype(jnp.float32)))
               + lam_init)
        y_b = diff_mixer(q1, q2, k1, k2, bv, lam, lam_init, g_subln[layer]).reshape(b, s, B_HEADS * B_V_DIM)

        x = x + jnp.concatenate([y_a, y_b], axis=-1) @ w_o[layer]
        x = x + moe(rms_norm(x, g_ffn[layer]), w_router[layer], b_router[layer],
                    w_gu[layer], b_gu[layer], w_down[layer], b_down[layer])
    return x
```

```cpp
#include <hip/hip_runtime.h>
#include <stdint.h>
#include <stdio.h>

typedef unsigned short bf16_t;
typedef short bf16x8 __attribute__((ext_vector_type(8)));
typedef short s16x4 __attribute__((ext_vector_type(4)));
typedef float f32x16 __attribute__((ext_vector_type(16)));
typedef float f32x4 __attribute__((ext_vector_type(4)));
typedef unsigned u32x4 __attribute__((ext_vector_type(4)));
typedef unsigned u32x2 __attribute__((ext_vector_type(2)));

constexpr int T_TOK = 65536, DM = 1024, SEQ = 2048, NBATCH = 32;
constexpr int NGROUP = 44;
constexpr int NEXP = 32, DEXP = 1024;
constexpr int NSLOT = T_TOK * 4;
constexpr float NORM_EPS = 1e-6f;
constexpr float QSCALE = 0.125f * 1.4426950408889634f;
constexpr float IW_SCALE = 0.04419417382415922f;
constexpr float LAM_INIT = 0.2f;

#define MIB(x) ((size_t)(x) << 20)
constexpr size_t WS_BAR = 0;
constexpr size_t WS_XRANK = 16384;
constexpr size_t WS_CNT = 65536;
constexpr size_t WS_EXP = 65536 + 32768;
constexpr size_t WS_CONST = 524288;
constexpr int C_BGU = 0, C_BDN = 65536, C_GQA = 98304, C_GKA = C_GQA + 64, C_GIK = C_GQA + 128, C_LQ1 = C_GQA + 192, C_LK1 = C_GQA + 256, C_LQ2 = C_GQA + 320,
              C_LK2 = C_GQA + 384, C_GQB = C_GQA + 448, C_GKB = C_GQA + 512, C_GSUB = C_GQA + 576, C_GFFN = C_GQA + 704, C_BRT = C_GQA + 1728, C_END = C_GQA + 1760;
constexpr size_t WS_TOPK_E = MIB(1);
constexpr size_t WS_TOPK_G = MIB(2);
constexpr size_t WS_TOKSLOT = MIB(3);
constexpr size_t WS_ROPE = MIB(4);
constexpr size_t WS_SLOTTOK = MIB(4);
constexpr size_t WS_WGU = MIB(8);
constexpr size_t WS_WD = MIB(72);
constexpr size_t WS_H2F8 = MIB(104);
constexpr size_t WS_WIN = MIB(200);
constexpr size_t WS_WR = MIB(200) + 5767168;
constexpr size_t WS_WO = MIB(206);
constexpr size_t WS_H = MIB(208);
constexpr size_t WS_QA = MIB(336);
constexpr size_t WS_QI = MIB(400);
constexpr size_t WS_QB = MIB(464);
constexpr size_t WS_KB = MIB(528);
constexpr size_t WS_VBT = MIB(592);
constexpr size_t WS_KA = MIB(656);
constexpr size_t WS_VAT = MIB(664);
constexpr size_t WS_KI = MIB(672);
constexpr size_t WS_WI = MIB(680);
constexpr size_t WS_YS = MIB(512);
constexpr size_t WS_X1B = MIB(768);
constexpr size_t WS_END = MIB(1024);

#define XB_TMO      128
#define XB_XCNT(j)  (256  + 64 * (j))
#define XB_XSUB(j)  (1280 + 64 * (j))
#define XB_XGEN(j)  (2304 + 64 * (j))
#define XB_TOP      3328
#define XB_TOPGEN   3392
#define XCD_BAR_WORDS 3456
#define XB_SPIN_CAP (1u << 18)
#define LAS __attribute__((address_space(3)))

__device__ __forceinline__ unsigned xb_ld(unsigned* p)              { return __hip_atomic_load(p, __ATOMIC_RELAXED, __HIP_MEMORY_SCOPE_AGENT); }
__device__ __forceinline__ unsigned xb_add(unsigned* p, unsigned v) { return __hip_atomic_fetch_add(p, v, __ATOMIC_RELAXED, __HIP_MEMORY_SCOPE_AGENT); }
__device__ __forceinline__ unsigned xb_xcc_id() { return (unsigned)__builtin_amdgcn_s_getreg((3 << 11) | 20) & 0xFu; }
#define XB_SPIN(cond, bar) do { unsigned _sp = 0; while (cond) { __builtin_amdgcn_s_sleep(1); \
    if ((++_sp & 255u) == 0u) { if (xb_ld(&(bar)[XB_TMO])) break; if (_sp > XB_SPIN_CAP) { atomicAdd(&(bar)[XB_TMO], 1u); break; } } } } while (0)

struct XcdBarrier { unsigned* bar; unsigned x; volatile LAS unsigned* st; };

__device__ __forceinline__ XcdBarrier xcd_barrier_post(unsigned* bar, volatile LAS unsigned* st, bool t0  ) {
    XcdBarrier b; b.bar = bar; b.x = xb_xcc_id(); b.st = st;
    if (t0) (void)xb_add(&bar[XB_XCNT(b.x)], 1u);
    return b;
}
__device__ __forceinline__ bool xcd_barrier_complete(unsigned* bar, unsigned x, unsigned& nloc, unsigned& nx) {
    const unsigned G = gridDim.x * gridDim.y * gridDim.z;
    unsigned sum, cnt, mine, sp = 0u; bool uni;
    for (;;) {
        sum = 0u; cnt = 0u; mine = 0u; uni = true;
#pragma unroll
        for (unsigned j = 0; j < 16; ++j) { const unsigned c = xb_ld(&bar[XB_XCNT(j)]); sum += c; cnt += (c > 0u) ? 1u : 0u; mine = (j == x) ? c : mine; uni = uni && (c == 0u || c * 8u == G); }
        if (sum == G) break;
        __builtin_amdgcn_s_sleep(1);
        if ((++sp & 255u) == 0u) { if (xb_ld(&bar[XB_TMO])) break; if (sp > XB_SPIN_CAP) { atomicAdd(&bar[XB_TMO], 1u); break; } }
    }
    nloc = mine > 0u ? mine : 1u; nx = cnt > 0u ? cnt : 1u;
    return sum == G && cnt == 8u && uni;
}
__device__ __forceinline__ void xcd_barrier_(const XcdBarrier& b, bool t0  ) {
    asm volatile("s_waitcnt vmcnt(0)" ::: "memory");
    __syncthreads();
    if (t0) {
        unsigned* bar = b.bar;
        __builtin_amdgcn_s_waitcnt(0);
        unsigned nloc = b.st[0], nx = b.st[1];
        if (nloc == 0u) { const bool uni = xcd_barrier_complete(bar, b.x, nloc, nx); b.st[0] = nloc; b.st[1] = nx; b.st[2] = uni ? 1u : 0u; }
        const unsigned old = xb_add(&bar[XB_XSUB(b.x)], 1u);
        const unsigned gen = old / nloc;
        if (old + 1u == (gen + 1u) * nloc) {
            __builtin_amdgcn_fence(__ATOMIC_RELEASE, "agent");
            asm volatile("s_waitcnt vmcnt(0)" ::: "memory");
            const unsigned og = xb_add(&bar[XB_TOP], 1u);
            const unsigned tg = og / nx;
            if (og + 1u == (tg + 1u) * nx) xb_add(&bar[XB_TOPGEN], 1u);
            else XB_SPIN(xb_ld(&bar[XB_TOPGEN]) == tg, bar);
            __builtin_amdgcn_fence(__ATOMIC_ACQUIRE, "agent");
            xb_add(&bar[XB_XGEN(b.x)], 1u);
            asm volatile("s_waitcnt vmcnt(0)" ::: "memory");
        } else {
            XB_SPIN(xb_ld(&bar[XB_XGEN(b.x)]) == gen, bar);
            __builtin_amdgcn_fence(__ATOMIC_ACQUIRE, "agent");
            asm volatile("s_waitcnt vmcnt(0)" ::: "memory");
        }
    }
    __syncthreads();
}

#define MFMA32(a, b, c) __builtin_amdgcn_mfma_f32_32x32x16_bf16((a), (b), (c), 0, 0, 0)
__device__ __forceinline__ int crow(int r, int h) { return (r & 3) + 8 * (r >> 2) + 4 * h; }
typedef __bf16 bf16x2_t __attribute__((ext_vector_type(2)));
typedef float f32x2_t __attribute__((ext_vector_type(2)));
__device__ __forceinline__ unsigned cvt_pk_bf16(float lo, float hi) { f32x2_t v; v.x = lo; v.y = hi; return __builtin_bit_cast(unsigned, __builtin_convertvector(v, bf16x2_t)); }

typedef int v8i32 __attribute__((ext_vector_type(8)));
constexpr float W8_SCALE = 32.0f;
constexpr int W8_E8M0 = 127 - 5, ONE_E8M0 = 127;
__device__ __forceinline__ unsigned cvt4_fp8(float a, float b, float c, float d) { int w = __builtin_amdgcn_cvt_pk_fp8_f32(a, b, 0, false); w = __builtin_amdgcn_cvt_pk_fp8_f32(c, d, w, true); return (unsigned)w; }
__device__ __forceinline__ float wave_sum(float v) {
#pragma unroll
    for (int o = 32; o >= 1; o >>= 1) v += __shfl_xor(v, o);
    return v;
}
__device__ __forceinline__ bf16x8 ldfrag(const bf16_t* p) { return *reinterpret_cast<const bf16x8*>(p); }
__device__ __forceinline__ bf16x8 pack8(const f32x16& v, int base) {
    u32x4 w; w.x = cvt_pk_bf16(v[base + 0], v[base + 1]); w.y = cvt_pk_bf16(v[base + 2], v[base + 3]);
    w.z = cvt_pk_bf16(v[base + 4], v[base + 5]); w.w = cvt_pk_bf16(v[base + 6], v[base + 7]);
    return __builtin_bit_cast(bf16x8, w);
}
__device__ __forceinline__ f32x16 zero16() { f32x16 z;
#pragma unroll
    for (int i = 0; i < 16; ++i) z[i] = 0.f; return z; }


struct Params {
    const float* in[22];
    float* out;
    unsigned char* ws;
};

#define CF(ws, off) ((const float*)((ws) + WS_CONST) + (off))

__device__ __forceinline__ int lane_id() { unsigned z = 0; asm volatile("" : "+v"(z));
    return (int)__builtin_amdgcn_mbcnt_hi(~0u, __builtin_amdgcn_mbcnt_lo(~0u, z)); }

__device__ __forceinline__ float bf_lo(unsigned w) { return __uint_as_float(w << 16); }
__device__ __forceinline__ float bf_hi(unsigned w) { return __uint_as_float(w & 0xffff0000u); }
struct Ctx {
    int tid, lane, wid, c, h, gw, nw, wg, nwg, mx, mk;
    LAS unsigned char* lds;
};

__device__ __forceinline__ void p0_rmsnorm_rows(const Ctx& X, const float* __restrict__ x, const float* __restrict__ g, bf16_t* __restrict__ H) {
    f32x4 gv[4];
#pragma unroll
    for (int i = 0; i < 4; ++i) gv[i] = ((const f32x4*)g)[X.lane + 64 * i];
    for (int base = X.gw * 4; base < T_TOK; base += X.nw * 4) {
        f32x4 v[4][4]; float ss[4];
#pragma unroll
        for (int r = 0; r < 4; ++r)
#pragma unroll
            for (int i = 0; i < 4; ++i) v[r][i] = __builtin_nontemporal_load((const f32x4*)(x + (size_t)(base + r) * DM) + X.lane + 64 * i);
#pragma unroll
        for (int r = 0; r < 4; ++r) { float a = 0.f;
#pragma unroll
            for (int i = 0; i < 4; ++i) a += v[r][i][0] * v[r][i][0] + v[r][i][1] * v[r][i][1] + v[r][i][2] * v[r][i][2] + v[r][i][3] * v[r][i][3];
            ss[r] = a; }
#pragma unroll
        for (int o = 32; o >= 1; o >>= 1)
#pragma unroll
            for (int r = 0; r < 4; ++r) ss[r] += __shfl_xor(ss[r], o);
#pragma unroll
        for (int r = 0; r < 4; ++r) {
            const float rinv = 1.0f / sqrtf(ss[r] * (1.0f / DM) + NORM_EPS);
#pragma unroll
            for (int i = 0; i < 4; ++i) {
                u32x2 w; w.x = cvt_pk_bf16(v[r][i][0] * rinv * gv[i][0], v[r][i][1] * rinv * gv[i][1]); w.y = cvt_pk_bf16(v[r][i][2] * rinv * gv[i][2], v[r][i][3] * rinv * gv[i][3]);
                *(u32x2*)(H + (size_t)(base + r) * DM + 4 * (X.lane + 64 * i)) = w;
            }
        }
    }
}

__device__ __forceinline__ void transpose_tile(const Ctx& X, const float* __restrict__ src, int ldsrc, int c0, int nvalid, int k0, bf16_t* __restrict__ dst, int ldd, int n0, int n0b = -1, const float* __restrict__ kscale = nullptr) {
    LAS float* tile = (LAS float*)X.lds;
    const int col = X.tid & 63, r0 = X.tid >> 6;
#pragma unroll
    for (int i = 0; i < 8; ++i) { const int row = r0 + 8 * i; float t_ = (col < nvalid) ? __builtin_nontemporal_load(src + (size_t)(k0 + row) * ldsrc + c0 + col) : 0.f; if (kscale) t_ *= kscale[k0 + row]; tile[row * 65 + col] = t_; }
    __syncthreads();
    const int nrow = X.tid >> 3, kseg = X.tid & 7;
    float v[8];
#pragma unroll
    for (int k = 0; k < 8; ++k) v[k] = tile[(kseg * 8 + k) * 65 + nrow];
    u32x4 w; w.x = cvt_pk_bf16(v[0], v[1]); w.y = cvt_pk_bf16(v[2], v[3]); w.z = cvt_pk_bf16(v[4], v[5]); w.w = cvt_pk_bf16(v[6], v[7]);
    const int drow = (n0b >= 0 && nrow >= 32) ? (n0b + nrow - 32) : (n0 + nrow);
    *(u32x4*)(dst + (size_t)drow * ldd + k0 + kseg * 8) = w;
    __syncthreads();
}

__device__ __forceinline__ void transpose_tile8(const Ctx& X, const float* __restrict__ src, int ldsrc, int c0, int k0, unsigned char* __restrict__ dst8, int ldd, int n0) {
    LAS float* tile = (LAS float*)X.lds;
    const int col = X.tid & 63, r0 = X.tid >> 6;
#pragma unroll
    for (int i = 0; i < 8; ++i) { const int row = r0 + 8 * i; tile[row * 65 + col] = __builtin_nontemporal_load(src + (size_t)(k0 + row) * ldsrc + c0 + col); }
    __syncthreads();
    const int nrow = X.tid >> 3, kseg = X.tid & 7;
    float v[8];
#pragma unroll
    for (int k = 0; k < 8; ++k) v[k] = tile[(kseg * 8 + k) * 65 + nrow] * W8_SCALE;
    u32x2 w; w.x = cvt4_fp8(v[0], v[1], v[2], v[3]); w.y = cvt4_fp8(v[4], v[5], v[6], v[7]);
    *(u32x2*)(dst8 + (size_t)(n0 + nrow) * ldd + k0 + kseg * 8) = w;
    __syncthreads();
}
__device__ __forceinline__ void win_group_src(int g, int& c0, int& nvalid) {
    nvalid = 64;
    if (g < 8) c0 = 64 * g;
    else if (g < 16) c0 = 640 + 64 * (g - 8);
    else if (g < 24) c0 = 1224 + 64 * (g - 16);
    else if (g < 32) c0 = 1736 + 64 * (g - 24);
    else if (g < 40) c0 = 2248 + 64 * (g - 32);
    else if (g == 40) c0 = 512;
    else if (g == 41) c0 = 576;
    else if (g == 42) c0 = 1152;
    else { c0 = 1216; nvalid = 8; }
}

__device__ __forceinline__ void p0_prologue(const Ctx& X, const Params& P) {
    unsigned char* ws = P.ws;
    {
        float* cst = (float*)(ws + WS_CONST);
        for (int i = X.wg * 512 + X.tid; i < C_END; i += X.nwg * 512) {
            float v;
            if (i < C_BDN) v = P.in[19][i];
            else if (i < C_GQA) v = P.in[21][i - C_BDN];
            else if (i < C_GKA) v = P.in[4][i - C_GQA];
            else if (i < C_GIK) v = P.in[5][i - C_GKA];
            else if (i < C_LQ1) v = P.in[6][i - C_GIK];
            else if (i < C_LK1) v = P.in[7][i - C_LQ1];
            else if (i < C_LQ2) v = P.in[8][i - C_LK1];
            else if (i < C_LK2) v = P.in[9][i - C_LQ2];
            else if (i < C_GQB) v = P.in[10][i - C_LK2];
            else if (i < C_GKB) v = P.in[11][i - C_GQB];
            else if (i < C_GSUB) v = P.in[12][i - C_GKB];
            else if (i < C_GFFN) v = P.in[13][i - C_GSUB];
            else if (i < C_BRT) v = P.in[15][i - C_GFFN];
            else v = P.in[17][i - C_BRT];
            cst[i] = v;
        }
    }
    p0_rmsnorm_rows(X, P.in[0], P.in[2], (bf16_t*)(ws + WS_H));
    {
        const int* pos = (const int*)P.in[1]; float* rope = (float*)(ws + WS_ROPE);
        for (int idx = X.wg * 512 + X.tid; idx < T_TOK * 8; idx += X.nwg * 512) {
            const int tok = idx >> 3, i = idx & 7;
            const float invf = i == 0 ? 1.0f : i == 1 ? 0.1939227432012558f : i == 2 ? 0.03760603070259094f : i == 3 ? 0.007292664609849453f : i == 4 ? 0.0014142135623842478f
                             : i == 5 ? 0.00027424818836152554f : i == 6 ? 5.3182957344688475e-05f : 1.0313385246263351e-05f;
            const float ang = (float)pos[tok] * invf;
            rope[tok * 16 + i] = cosf(ang); rope[tok * 16 + 8 + i] = sinf(ang);
        }
    }
    {
        const int ntile = 32 * 32 * 16;
        for (int t = X.wg; t < ntile; t += X.nwg) {
            const int kt = t & 15, q = (t >> 4) & 31, e = t >> 9;
            const int u = q >> 2, w = q & 3; const int c0 = (w < 2) ? (128 * u + 64 * w) : (1024 + 128 * u + 64 * (w - 2));
            transpose_tile8(X, P.in[18] + (size_t)e * 1024 * 2048, 2048, c0, kt * 64, ws + WS_WGU + (size_t)e * 2048 * 1024, 1024, q * 64);
        }
    }
    {
        const int ntile = 32 * 16 * 16;
        for (int t = X.wg; t < ntile; t += X.nwg) {
            const int kt = t & 15, q = (t >> 4) & 15, e = t >> 8;
            transpose_tile8(X, P.in[20] + (size_t)e * 1024 * 1024, 1024, q * 64, kt * 64, ws + WS_WD + (size_t)e * 1024 * 1024, 1024, q * 64);
        }
    }
    {
        const int ntile = NGROUP * 16;
        for (int t = X.wg; t < ntile; t += X.nwg) {
            const int kt = t & 15, g = t >> 4; int c0, nv; win_group_src(g, c0, nv);
            transpose_tile(X, P.in[3], 2760, c0, nv, kt * 64, (bf16_t*)(ws + WS_WIN), 1024, 256 * (g >> 2) + 32 * (g & 3), 256 * (g >> 2) + 128 + 32 * (g & 3));
        }
    }
    {
        for (int t = X.wg; t < 256; t += X.nwg) { const int kt = t & 15, q = t >> 4; transpose_tile(X, P.in[14], 1024, q * 64, 64, kt * 64, (bf16_t*)(ws + WS_WO), 1024, q * 64); }
    }
    {
        for (int t = X.wg; t < 16; t += X.nwg) transpose_tile(X, P.in[16], 32, 0, 32, t * 64, (bf16_t*)(ws + WS_WR), 1024, 0, -1, P.in[15]);
    }
}

typedef short v4i16_t __attribute__((ext_vector_type(4)));
__device__ __forceinline__ s16x4 tr16(const LAS unsigned char* p) { return __builtin_bit_cast(s16x4, __builtin_amdgcn_ds_read_tr16_b64_v4i16((LAS v4i16_t*)p)); }
__device__ __forceinline__ void dma16(const void* g, LAS unsigned char* l) {
    const unsigned base = (unsigned)__builtin_amdgcn_readfirstlane((int)(unsigned)(uintptr_t)l); unsigned sv;
    asm volatile("s_mov_b32 %0, m0\n\ts_mov_b32 m0, %2\n\ts_nop 0\n\tglobal_load_lds_dwordx4 %1, off\n\ts_mov_b32 m0, %0" : "=&s"(sv) : "v"(g), "s"(base) : "memory"); }
__device__ __forceinline__ bf16x8 ldsfrag(const LAS unsigned char* p) { return *(const LAS bf16x8*)p; }
constexpr int L2_FB = 1024, L2_CB = 5120, L2_ZM = 9216  , L2_WL = 17408, L2_ZT = 18432, L2_QI = 20480, L2_M8 = 20480  ,
              L2_XB = 20480  , L2_KIW = 53248  , L2_KVB = 86016  , L2_DIFF = 20480;


__device__ __forceinline__ void count_ge4(int& c0, int& c1, float x0, float x1, float x2, float x3, float t) {
    unsigned long long m0, m1, m2, m3;
    asm volatile("v_cmp_ge_f32_e64 %2, %6, %10\n\tv_cmp_ge_f32_e64 %3, %7, %10\n\tv_cmp_ge_f32_e64 %4, %8, %10\n\tv_cmp_ge_f32_e64 %5, %9, %10\n\t"
                 "v_addc_co_u32_e64 %0, vcc, 0, %0, %2\n\tv_addc_co_u32_e64 %1, vcc, 0, %1, %3\n\tv_addc_co_u32_e64 %0, vcc, 0, %0, %4\n\tv_addc_co_u32_e64 %1, vcc, 0, %1, %5"
                 : "+v"(c0), "+v"(c1), "=&s"(m0), "=&s"(m1), "=&s"(m2), "=&s"(m3) : "v"(x0), "v"(x1), "v"(x2), "v"(x3), "v"(t) : "vcc");
}

__device__ __forceinline__ void dsa_unit(const Ctx& X, const Params& P, LAS unsigned char* ldsall, int b, int qt) {
    unsigned char* ws = P.ws;
    const bf16_t* QI = (const bf16_t*)(ws + WS_QI); const bf16_t* KI = (const bf16_t*)(ws + WS_KI); const float* WI = (const float*)(ws + WS_WI);
    const bf16_t* QA = (const bf16_t*)(ws + WS_QA); const bf16_t* KA = (const bf16_t*)(ws + WS_KA); const bf16_t* VA = (const bf16_t*)(ws + WS_VAT);
    bf16_t* Y = (bf16_t*)(ws + WS_H);
    const int wid = X.wid, lane = lane_id(), c = lane & 31, h = lane >> 5;
    const int q0 = qt * 32, chunk = q0 >> 6, nkb = 2 * (chunk + 1);
    const int tokq = b * SEQ + q0 + c;
    LAS float* fb = (LAS float*)(ldsall + L2_FB);
    LAS int* cb = (LAS int*)(ldsall + L2_CB);
    LAS unsigned char* m8 = ldsall + L2_M8;
    LAS unsigned char* qis = ldsall + L2_QI;
    LAS unsigned char* kv = ldsall + L2_KVB;
#define KVSLOT(tt) (kv + (((tt) + 2) % 3) * 16384)
    __syncthreads();
    const bf16_t* ksrc = KA + (size_t)b * 131072 + wid * 512 + lane * 8;
    const bf16_t* vsrc = VA + (size_t)(b * SEQ + 16 * (wid & 3) + (lane >> 2)) * 64 + (wid >> 2) * 32 + (lane & 3) * 8;
    dma16(ksrc, KVSLOT(0) + wid * 1024); dma16(vsrc, KVSLOT(0) + 8192 + wid * 1024);
    if (nkb <= 8) {
        *(LAS u32x4*)(m8 + (wid * 64 + lane) * 16) = (u32x4){0u, 0u, 0u, 0u};
    } else {
        LAS float* wl = (LAS float*)(ldsall + L2_WL);
        if (wid == 0 && h == 0) { *(LAS f32x4*)(wl + c * 8) = *(const f32x4*)(WI + (size_t)tokq * 8); *(LAS f32x4*)(wl + c * 8 + 4) = *(const f32x4*)(WI + (size_t)tokq * 8 + 4); }
#pragma unroll
        for (int i = 0; i < 4; ++i) { const int piece = wid * 4 + i, head = piece >> 2, cp = piece & 3;
            dma16(QI + (size_t)(b * SEQ + q0 + (lane & 31)) * 512 + head * 64 + (2 * cp + (lane >> 5)) * 8, qis + piece * 1024); }
        asm volatile("s_waitcnt vmcnt(0)" ::: "memory");
        __syncthreads();
        f32x16 sc[8];
        LAS unsigned char* kiw = ldsall + L2_KIW + wid * 8192;
        const bf16_t* kisrc = KI + (size_t)b * 131072 + lane * 8;
#define KI_DMA(kb_, buf_) do { _Pragma("unroll") for (int j_ = 0; j_ < 4; ++j_) dma16(kisrc + (size_t)(kb_) * 2048 + 512 * j_, kiw + (buf_) * 4096 + j_ * 1024); } while (0)
        KI_DMA(wid, 0);
#pragma unroll
        for (int i = 0; i < 8; ++i) {
            const int kb = wid + 8 * i;
            f32x16 a = zero16();
            if (kb < nkb) {
                if (i < 7 && kb + 8 < nkb) { KI_DMA(kb + 8, (i + 1) & 1); asm volatile("s_waitcnt vmcnt(4)" ::: "memory"); }
                else asm volatile("s_waitcnt vmcnt(0)" ::: "memory");
                const LAS unsigned char* kbuf = kiw + (i & 1) * 4096;
                bf16x8 kf[4];
#pragma unroll
                for (int s = 0; s < 4; ++s) kf[s] = ldsfrag(kbuf + (2 * s + h) * 512 + c * 16);
                float wcur = wl[c * 8];
#pragma unroll 1
                for (int hd = 0; hd < 8; ++hd) {
                    const float wnext = wl[c * 8 + ((hd + 1) & 7)];
                    f32x16 S = zero16();
#pragma unroll
                    for (int s = 0; s < 4; ++s) S = MFMA32(kf[s], ldsfrag(qis + hd * 4096 + (2 * s + h) * 512 + c * 16), S);
#pragma unroll
                    for (int r = 0; r < 16; ++r) { const float rl = __builtin_amdgcn_fmed3f(S[r], 0.0f, 3.0e38f);
                        asm("v_fmac_f32 %0, %1, %2" : "+v"(a[r]) : "v"(wcur), "v"(rl)); }
                    wcur = wnext;
                }
            } else {
#pragma unroll
                for (int r = 0; r < 16; ++r) a[r] = -INFINITY;
            }
            sc[i] = a;
        }
#undef KI_DMA
        const int cq = 4 * wid + (lane >> 4), pl = lane & 15;
        {
            LAS unsigned char* xw = ldsall + L2_XB + (2 * wid + h) * 2064 + c * 64; const int swz_w = (c >> 2) & 3;
            LAS unsigned char* xr = ldsall + L2_XB + pl * 2064 + cq * 64; const int swz_r = (cq >> 2) & 3;
            __syncthreads();
#pragma unroll
            for (int i = 0; i < 8; ++i) if (8 * i < nkb) {
#pragma unroll
                for (int q4 = 0; q4 < 4; ++q4) *(LAS f32x4*)(xw + (i & 1) * 33024 + 16 * (q4 ^ swz_w)) = (f32x4){sc[i][4 * q4], sc[i][4 * q4 + 1], sc[i][4 * q4 + 2], sc[i][4 * q4 + 3]};
                __syncthreads();
#pragma unroll
                for (int q4 = 0; q4 < 4; ++q4) { const f32x4 v = *(const LAS f32x4*)(xr + (i & 1) * 33024 + 16 * (q4 ^ swz_r)); sc[i][4 * q4] = v[0]; sc[i][4 * q4 + 1] = v[1]; sc[i][4 * q4 + 2] = v[2]; sc[i][4 * q4 + 3] = v[3]; }
            }
            __syncthreads();
        }
#define DPP_I(x, ctrl) __builtin_amdgcn_update_dpp(0, (x), (ctrl), 0xF, 0xF, true)
#define DPP_F(x, ctrl) __int_as_float(DPP_I(__float_as_int(x), (ctrl)))
        float mn = INFINITY, mx = -INFINITY;
#pragma unroll
        for (int i = 0; i < 8; ++i) if (8 * i < nkb) {
            const bool val = (pl >> 1) + 8 * i < nkb;
#pragma unroll
            for (int r = 0; r < 16; ++r) { mn = fminf(mn, val ? sc[i][r] : INFINITY); mx = fmaxf(mx, sc[i][r]); }
        }
        mn = fminf(mn, DPP_F(mn, 0xB1)); mn = fminf(mn, DPP_F(mn, 0x4E)); mn = fminf(mn, DPP_F(mn, 0x141)); mn = fminf(mn, DPP_F(mn, 0x140));
        mx = fmaxf(mx, DPP_F(mx, 0xB1)); mx = fmaxf(mx, DPP_F(mx, 0x4E)); mx = fmaxf(mx, DPP_F(mx, 0x141)); mx = fmaxf(mx, DPP_F(mx, 0x140));
        float lo = mn, hi = mx;
        bool done = false; float thr = lo; int tot0 = 0;
        LAS int* ztl = (LAS int*)(ldsall + L2_ZT) + wid * 64 + lane;
        int nval = 0;
#pragma unroll
        for (int i = 0; i < 8; ++i) nval += (8 * i < nkb) ? 16 : 0;
        for (int it = 0; it < 66; ++it) {
            const float mid = 0.5f * lo + 0.5f * hi;
            const bool degenerate = !(mid > lo && mid < hi);
            const float t = done ? thr : (it == 0 ? 1e-30f : (it == 1 ? 0.0f : mid));
            unsigned a0 = 0u, a1 = 0u, a2 = 0u, a3 = 0u; const f32x2_t tt = (f32x2_t){t, t};
#pragma unroll
            for (int i = 0; i < 8; ++i) if (8 * i < nkb) {
#pragma unroll
                for (int r = 0; r < 16; r += 4) {
                    const f32x2_t d01 = (f32x2_t){sc[i][r], sc[i][r + 1]} - tt, d23 = (f32x2_t){sc[i][r + 2], sc[i][r + 3]} - tt;
                    a0 = __builtin_amdgcn_alignbit(a0, __float_as_uint(d01.x), 31); a1 = __builtin_amdgcn_alignbit(a1, __float_as_uint(d01.y), 31);
                    a2 = __builtin_amdgcn_alignbit(a2, __float_as_uint(d23.x), 31); a3 = __builtin_amdgcn_alignbit(a3, __float_as_uint(d23.y), 31);
                }
            }
            int tot = nval - (__builtin_popcount(a0) + __builtin_popcount(a1) + __builtin_popcount(a2) + __builtin_popcount(a3));
            tot += DPP_I(tot, 0xB1); tot += DPP_I(tot, 0x4E); tot += DPP_I(tot, 0x141); tot += DPP_I(tot, 0x140);
#define ZERO_PROBES(c0, c1) do { *ztl = ((c0) > 256 && (c1) < 256) ? 256 - (c1) : -1; \
                if ((c0) >= 256 && (c1) < 256) { done = true; thr = 0.0f; } \
                else if ((c1) >= 256) { lo = fmaxf(lo, 1e-30f); if ((c1) == 256) { done = true; thr = 1e-30f; } } \
                else hi = fminf(hi, 0.0f); } while (0)
            if (it == 0) { tot0 = tot;
                if (!__any(tot < 256)) { ZERO_PROBES(tot, tot); it = 1; } }
            else if (it == 1) ZERO_PROBES(tot, tot0);
            else if (!done) {
                if (degenerate) { done = true; thr = lo; }
                else if (tot == 256) { done = true; thr = mid; }
                else if (tot > 256) lo = mid; else hi = mid;
            }
#undef ZERO_PROBES
            if (__all(done)) break;
        }
#undef DPP_I
#undef DPP_F
        if (!done) thr = lo;
        const int ztake = *ztl; const bool tie = ztake >= 0;
        const int hn = pl & 1;
#pragma unroll
        for (int i = 0; i < 8; ++i) if (8 * i < nkb) {
            u32x4 w = (u32x4){0u, 0u, 0u, 0u};
#pragma unroll
            for (int r = 0; r < 16; ++r) w[r >> 2] |= (sc[i][r] >= thr) ? 0u : (0xFEu << (8 * (r & 3)));
            *(LAS u32x4*)(m8 + ((pl + 16 * i) * 32 + cq) * 16) = w;
        }
        if (__any(tie)) {
            LAS unsigned short* zmask16 = (LAS unsigned short*)(ldsall + L2_ZM);
#pragma unroll
            for (int i = 0; i < 8; ++i) if (8 * i < nkb) {
                unsigned z = 0;
#pragma unroll
                for (int r = 0; r < 16; ++r) z |= (sc[i][r] == 0.0f) ? (1u << r) : 0u;
                zmask16[cq * 128 + pl + 16 * i] = (unsigned short)z;
            }
            asm volatile("s_waitcnt lgkmcnt(0)" ::: "memory");
            const LAS unsigned* zw = (const LAS unsigned*)(ldsall + L2_ZM);
            int prefix = 0, kdone = 0;
#pragma unroll 1
            for (int kb = pl >> 1; kb < nkb; kb += 8) {
#pragma unroll 1
                for (; kdone < kb; ++kdone) prefix += __builtin_popcount(zw[cq * 64 + kdone]);
                const unsigned w = zw[cq * 64 + kb], b0 = w & 0xffffu, b1 = w >> 16;
                unsigned W = 0;
#pragma unroll
                for (int g = 0; g < 4; ++g) W |= (((b0 >> (4 * g)) & 0xfu) << (8 * g)) | (((b1 >> (4 * g)) & 0xfu) << (8 * g + 4));
                const unsigned mine = hn ? b1 : b0; unsigned add = 0;
#pragma unroll
                for (int r = 0; r < 16; ++r) { const int rho = crow(r, hn); const int rank = prefix + __builtin_popcount(W & ((1u << rho) - 1u)); add |= (((mine >> r) & 1u) && rank >= ztake) ? (1u << r) : 0u; }
                if (tie) { LAS u32x4* mp_ = (LAS u32x4*)(m8 + ((kb * 2 + hn) * 32 + cq) * 16); u32x4 w2 = *mp_;
#pragma unroll
                    for (int r = 0; r < 16; ++r) w2[r >> 2] |= (0u - ((add >> r) & 1u)) & (0xFEu << (8 * (r & 3)));
                    *mp_ = w2; }
            }
        }
    }
    {
        const bf16_t* qp = QA + (size_t)tokq * 512 + wid * 64 + 8 * h;
        bf16x8 qr[4];
#pragma unroll
        for (int s = 0; s < 4; ++s) qr[s] = ldfrag(qp + 16 * s);
        asm volatile("" : "+v"(qr[0]), "+v"(qr[1]), "+v"(qr[2]), "+v"(qr[3]));
        f32x16 O[2]; O[0] = zero16(); O[1] = zero16(); float l = 0.f;
        const int vbase = ((lane >> 4) & 1) * 32 + (lane & 3) * 8 + (4 * h + ((lane & 15) >> 2)) * 64;
        const int lane2 = lane_id();
        const bf16_t* ksrc2 = KA + (size_t)b * 131072 + wid * 512 + lane2 * 8;
        const bf16_t* vsrc2 = VA + (size_t)(b * SEQ + 16 * (wid & 3) + (lane2 >> 2)) * 64 + (wid >> 2) * 32 + (lane2 & 3) * 8;
#define DSA_DMA(tt) do { LAS unsigned char* ns_ = KVSLOT(tt); dma16(ksrc2 + (size_t)(tt) * 4096, ns_ + wid * 1024); dma16(vsrc2 + (size_t)(tt) * 64 * 64, ns_ + 8192 + wid * 1024); } while (0)
        if (chunk >= 1) DSA_DMA(1);
        for (int t = 0; t <= chunk; ++t) {
            if (t + 1 <= chunk) asm volatile("s_waitcnt vmcnt(2)" ::: "memory"); else asm volatile("s_waitcnt vmcnt(0)" ::: "memory");
            __syncthreads();
            if (t + 2 <= chunk) DSA_DMA(t + 2);
            const LAS unsigned char* ks = KVSLOT(t) + (h * 1024 + c * 16); const LAS unsigned char* vs = KVSLOT(t) + 8192 + vbase;
            asm volatile("" : "+v"(ks), "+v"(vs));
            f32x16 S[2];
#pragma unroll
            for (int blk = 0; blk < 2; ++blk) {
                const u32x4 mw = *(const LAS u32x4*)(m8 + (((2 * t + blk) * 2 + h) * 32 + c) * 16);
                f32x16 a;
#pragma unroll
                for (int r = 0; r < 16; ++r) a[r] = __uint_as_float(mw[r >> 2] << (24 - 8 * (r & 3)));
#pragma unroll
                for (int s = 0; s < 4; ++s) a = MFMA32(ldsfrag(ks + 2048 * s + 512 * blk), qr[s], a);
#pragma unroll
                for (int r = 0; r < 16; ++r) { const float p = __builtin_amdgcn_exp2f(a[r]); l += p; a[r] = p; }
                S[blk] = a;
            }
#pragma unroll
            for (int s4 = 0; s4 < 4; ++s4) {
                const bf16x8 pf = pack8(S[s4 >> 1], 8 * (s4 & 1));
#pragma unroll
                for (int db = 0; db < 2; ++db) {
                    const s16x4 v0 = tr16(vs + db * 4096 + s4 * 1024), v1 = tr16(vs + db * 4096 + s4 * 1024 + 512);
                    const bf16x8 vf = (bf16x8){v0[0], v0[1], v0[2], v0[3], v1[0], v1[1], v1[2], v1[3]};
                    O[db] = MFMA32(vf, pf, O[db]);
                }
            }
        }
#undef DSA_DMA
#undef KVSLOT
        l += __shfl_xor(l, 32);
        const float inv = 1.0f / l;
        int hh = h; asm volatile("" : "+v"(hh));
        bf16_t* yrow = Y + (size_t)tokq * DM + wid * 64;
        u32x2 w[8];
#pragma unroll
        for (int db = 0; db < 2; ++db)
#pragma unroll
            for (int rg = 0; rg < 4; ++rg) { w[4 * db + rg].x = cvt_pk_bf16(O[db][4 * rg] * inv, O[db][4 * rg + 1] * inv); w[4 * db + rg].y = cvt_pk_bf16(O[db][4 * rg + 2] * inv, O[db][4 * rg + 3] * inv); }
        unsigned char* yb = (unsigned char*)yrow + 16 * hh;
#pragma unroll
        for (int k = 0; k < 8; k += 2) {
            const auto rx = __builtin_amdgcn_permlane32_swap(w[k].x, w[k + 1].x, false, false), ry = __builtin_amdgcn_permlane32_swap(w[k].y, w[k + 1].y, false, false);
            *(u32x4*)(yb + 16 * k) = (u32x4){(unsigned)rx[0], (unsigned)ry[0], (unsigned)rx[1], (unsigned)ry[1]};
        }
    }
}

__device__ __forceinline__ void diff_unit(const Ctx& X, const Params& P, LAS unsigned char* ldsall, int b, int hb, int qt16, float lam) {
    unsigned char* ws = P.ws;
    const bf16_t* QB = (const bf16_t*)(ws + WS_QB); const bf16_t* KB = (const bf16_t*)(ws + WS_KB); const bf16_t* VB = (const bf16_t*)(ws + WS_VBT);
    bf16_t* Y = (bf16_t*)(ws + WS_H);
    const float* gsub = CF(ws, C_GSUB);
    const int wid = X.wid, lane = lane_id(), c = lane & 31, h = lane >> 5, qg = wid & 3, mp = wid >> 2;
    const int q0 = qt16 * 128 + 32 * qg, chunk = q0 >> 6, ntile = 2 * qt16 + 2;
    const int tokq = b * SEQ + q0 + c;
    LAS unsigned char* ring = ldsall + L2_DIFF;
    bf16x8 qf[4];
    { const bf16_t* qp = QB + (size_t)tokq * 512 + hb * 128 + mp * 64 + 8 * h;
#pragma unroll
      for (int s = 0; s < 4; ++s) qf[s] = ldfrag(qp + 16 * s); }
    asm volatile("" : "+v"(qf[0]), "+v"(qf[1]), "+v"(qf[2]), "+v"(qf[3]));
    const bf16_t* k1src = KB + (size_t)((b * 4 + hb) * 2) * 131072 + wid * 512 + lane * 8;
    const bf16_t* vsrc0 = VB + (size_t)(b * SEQ + 16 * (wid & 3) + (lane >> 2)) * 512 + hb * 128 + (wid >> 2) * 32 + (lane & 3) * 8;
    __syncthreads();
#define DIFF_DMA(tt) do { LAS unsigned char* ns_ = ring + ((tt) % 3) * 32768; const bf16_t* kn_ = k1src + (size_t)(tt) * 4096; const bf16_t* vn_ = vsrc0 + (size_t)(tt) * 64 * 512; \
        dma16(kn_, ns_ + wid * 1024); dma16(kn_ + 131072, ns_ + 8192 + wid * 1024); dma16(vn_, ns_ + 16384 + wid * 1024); dma16(vn_ + 64, ns_ + 16384 + (wid + 8) * 1024); } while (0)
    DIFF_DMA(0); if (ntile > 1) DIFF_DMA(1);
    f32x16 O[4];
#pragma unroll
    for (int db = 0; db < 4; ++db) O[db] = zero16();
    float l = 0.f;
    const int vbase = ((lane >> 4) & 1) * 32 + (lane & 3) * 8 + (4 * h + ((lane & 15) >> 2)) * 64;
    for (int t = 0; t < ntile; ++t) {
        if (t + 1 < ntile) asm volatile("s_waitcnt vmcnt(4)" ::: "memory"); else asm volatile("s_waitcnt vmcnt(0)" ::: "memory");
        __syncthreads();
        if (t + 2 < ntile) DIFF_DMA(t + 2);
        if (t <= chunk) {
            const LAS unsigned char* ks = ring + (t % 3) * 32768 + mp * 8192 + (h * 1024 + c * 16); const LAS unsigned char* vs = ring + (t % 3) * 32768 + 16384 + vbase;
            asm volatile("" : "+v"(ks), "+v"(vs));
            f32x16 A[2];
#pragma unroll
            for (int blk = 0; blk < 2; ++blk) {
                f32x16 s1 = zero16();
#pragma unroll
                for (int s = 0; s < 4; ++s) s1 = MFMA32(ldsfrag(ks + 2048 * s + 512 * blk), qf[s], s1);
#pragma unroll
                for (int r = 0; r < 16; ++r) { s1[r] = __builtin_amdgcn_exp2f(s1[r]); l += s1[r]; }
                A[blk] = s1;
            }
#pragma unroll
            for (int s4 = 0; s4 < 4; ++s4) {
                const bf16x8 pf = pack8(A[s4 >> 1], 8 * (s4 & 1));
#pragma unroll
                for (int db = 0; db < 4; ++db) {
                    const s16x4 v0 = tr16(vs + db * 4096 + s4 * 1024), v1 = tr16(vs + db * 4096 + s4 * 1024 + 512);
                    const bf16x8 vf = (bf16x8){v0[0], v0[1], v0[2], v0[3], v1[0], v1[1], v1[2], v1[3]};
                    O[db] = MFMA32(vf, pf, O[db]);
                }
            }
        }
    }
#undef DIFF_DMA
    l += __shfl_xor(l, 32);
    __syncthreads();
    LAS float* comb = (LAS float*)ring + qg * 4096;
    if (mp == 1) {
        const float sc = lam / l;
#pragma unroll
        for (int db = 0; db < 4; ++db)
#pragma unroll
            for (int r = 0; r < 16; ++r) comb[(db * 16 + r) * 64 + lane] = O[db][r] * sc;
    }
    __syncthreads();
    if (mp == 0) {
        const float inv = 1.0f / l;
        float ss = 0.f;
#pragma unroll
        for (int db = 0; db < 4; ++db)
#pragma unroll
            for (int r = 0; r < 16; ++r) { const float o = O[db][r] * inv - comb[(db * 16 + r) * 64 + lane]; O[db][r] = o; ss += o * o; }
        ss += __shfl_xor(ss, 32);
        const float rinv = (1.0f - LAM_INIT) / sqrtf(ss * (1.0f / 128.0f) + NORM_EPS);
        int hh = h; asm volatile("" : "+v"(hh));
        bf16_t* yrow = Y + (size_t)tokq * DM + 512 + hb * 128;
        unsigned char* yb = (unsigned char*)yrow + 16 * hh;
#pragma unroll
        for (int db = 0; db < 4; ++db)
#pragma unroll
            for (int rp = 0; rp < 4; rp += 2) {
                u32x2 w[2];
#pragma unroll
                for (int q = 0; q < 2; ++q) { const int rg = rp + q, d = 32 * db + 8 * rg + 4 * hh;
                    const f32x4 gv = *(const f32x4*)(gsub + d);
                    w[q].x = cvt_pk_bf16(O[db][4 * rg] * rinv * gv[0], O[db][4 * rg + 1] * rinv * gv[1]); w[q].y = cvt_pk_bf16(O[db][4 * rg + 2] * rinv * gv[2], O[db][4 * rg + 3] * rinv * gv[3]); }
                const auto rx = __builtin_amdgcn_permlane32_swap(w[0].x, w[1].x, false, false), ry = __builtin_amdgcn_permlane32_swap(w[0].y, w[1].y, false, false);
                *(u32x4*)(yb + 16 * (4 * db + rp)) = (u32x4){(unsigned)rx[0], (unsigned)ry[0], (unsigned)rx[1], (unsigned)ry[1]};
            }
    }
}

__device__ __forceinline__ void p2_mixers(const Ctx& X, const Params& P, LAS unsigned char* ldsall) {
    const bool xl = (X.nwg & 7) == 0; const int gx = X.nwg >> 3;
    for (int i = 0;; ++i) {
        int u; if (xl) { const int v = X.mk + gx * i; if (v >= 128) break; u = X.mx * 128 + v; } else { u = X.wg + X.nwg * i; if (u >= NBATCH * 32) break; }
        const int b = u >> 5, j = ((u & 31) + (((X.nwg & 31) == 0) ? 8 * i : 0)) & 31;
        dsa_unit(X, P, ldsall, b, j);
        dsa_unit(X, P, ldsall, b, 63 - j);
    }
    float lam;
    { const float a = wave_sum(CF(P.ws, C_LQ1)[X.lane] * CF(P.ws, C_LK1)[X.lane]), bq = wave_sum(CF(P.ws, C_LQ2)[X.lane] * CF(P.ws, C_LK2)[X.lane]); lam = expf(a) - expf(bq) + LAM_INIT; }
    for (int i = 0;; ++i) {
        int u; if (xl) { const int v = X.mk + gx * i; if (v >= 128) break; u = X.mx * 128 + v; } else { u = X.wg + X.nwg * i; if (u >= NBATCH * 4 * 8) break; }
        const int j = u & 7, hb = (u >> 3) & 3, b = u >> 5;
        diff_unit(X, P, ldsall, b, hb, j, lam);
        diff_unit(X, P, ldsall, b, hb, 15 - j, lam);
    }
}

namespace g8 {
typedef float f32x4 __attribute__((ext_vector_type(4)));
constexpr int BM = 256, BK = 64, HALF = 128, HTB = HALF * BK * 2, STAGE_BYTES = 8 * HTB, KDIM = 1024, NT = KDIM / BK;
__device__ __forceinline__ int lds_byte(int r, int c) { const int st = (r >> 4) * 2 + (c >> 5), rr = r & 15, cc = c & 31, ob = rr * 64 + cc * 2; return st * 1024 + (ob ^ (((ob >> 9) & 1) << 5)); }
__device__ __forceinline__ void stage_rc(int b, int& R, int& C) { const int st = b / 1024, sb = b % 1024, swz = sb ^ (((sb >> 9) & 1) << 5); R = (st >> 1) * 16 + swz / 64; C = (st & 1) * 32 + (swz % 64) / 2; }
__device__ __forceinline__ int perm32(int rho) { const int n = rho >> 4, i = rho & 15; return 8 * (i >> 2) + 4 * n + (i & 3); }

struct Unit { int rt, pn, e, row0, nvalid; };

template <class Epi, class Sched, bool GATHER, bool F8 = false>
__device__ __forceinline__ void gemm_phase(LAS unsigned char* lds, LAS unsigned char* ldsidx, const Sched& S, const Epi& E, int wid_) {
    int lane = lane_id(); asm volatile("" : "+v"(lane));
    const int wid = wid_, tid = wid * 64 + lane, wr = wid >> 2, wc = wid & 3, fr = lane & 15, fq = lane >> 4;
    constexpr int RP = F8 ? 1024 : 2048, nt = RP / 128;
    unsigned voffB[2], cu[2][2];
#pragma unroll
    for (int i = 0; i < 2; ++i) { int R, C; stage_rc(tid * 16 + i * 8192, R, C); const int Rb = Epi::PERM ? ((R & ~31) + perm32(R & 31)) : R;
        voffB[i] = (unsigned)(Rb * RP + C * 2);
        cu[0][i] = (unsigned)(R * RP + C * 2); cu[1][i] = (unsigned)((R + HALF) * RP + C * 2); }
    const size_t kstep = (size_t)(BK * 2);
    const size_t hstep = (size_t)HALF * RP;
    const unsigned lbase = (unsigned)__builtin_amdgcn_readfirstlane((int)((unsigned)(uintptr_t)lds + (unsigned)wid * 1024u));
    const int aoff = F8 ? lds_byte(wr * 64 + fr, fq * 16) : lds_byte(wr * 64 + fr, fq * 8), boff = F8 ? lds_byte(wc * 32 + fr, fq * 16) : lds_byte(wc * 32 + fr, fq * 8);
    constexpr int KOFF = F8 ? 16 : 1024;
#define G8_SA(b, h) (((b) * 2 + (h)) * HTB)
#define G8_SB(b, h) ((4 + (b) * 2 + (h)) * HTB)
#define G8_DMA(gbase, voff, ldsoff) do { unsigned sv_; \
        asm volatile("s_mov_b32 %0, m0\n\ts_add_u32 m0, %3, %4\n\ts_nop 0\n\tglobal_load_lds_dwordx4 %1, %2\n\ts_mov_b32 m0, %0" : "=&s"(sv_) : "v"(voff), "s"(gbase), "s"(lbase), "n"(ldsoff) : "memory", "scc"); } while (0)
#define G8_STAGEB(bufoff, gbase) do { G8_DMA((gbase), voffB[0], (bufoff)); G8_DMA((gbase), voffB[1], (bufoff) + 8192); } while (0)
#define G8_STAGEA_(bufoff, gbase, o0, o1) do { G8_DMA((gbase), (o0), (bufoff)); G8_DMA((gbase), (o1), (bufoff) + 8192); } while (0)
#define G8_STAGEA(bufoff, gbase, hh) do { if constexpr (GATHER) { G8_STAGEA_(bufoff, gbase, cu[hh][0], cu[hh][1]); } else { G8_STAGEA_(bufoff, (gbase) + (hh) * hstep, cu[0][0], cu[0][1]); } } while (0)
#define G8_LDA(dst, b, h) do { _Pragma("unroll") for (int m = 0; m < 4; ++m) _Pragma("unroll") for (int k = 0; k < 2; ++k) dst[m][k] = *(const LAS bf16x8*)(lds + G8_SA(b, h) + aoff + m * 2048 + k * KOFF); } while (0)
#define G8_LDB(dst, b, h) do { _Pragma("unroll") for (int n = 0; n < 2; ++n) _Pragma("unroll") for (int k = 0; k < 2; ++k) dst[n][k] = *(const LAS bf16x8*)(lds + G8_SB(b, h) + boff + n * 2048 + k * KOFF); } while (0)
#define G8_MMA(ai, bj, At, Bt) do { __builtin_amdgcn_s_setprio(1); \
        if constexpr (F8) { _Pragma("unroll") for (int m = 0; m < 4; ++m) _Pragma("unroll") for (int n = 0; n < 2; ++n) { \
            const u32x4 b0_ = __builtin_bit_cast(u32x4, Bt[n][0]), b1_ = __builtin_bit_cast(u32x4, Bt[n][1]), a0_ = __builtin_bit_cast(u32x4, At[m][0]), a1_ = __builtin_bit_cast(u32x4, At[m][1]); \
            const v8i32 bw_ = (v8i32){(int)b0_.x, (int)b0_.y, (int)b0_.z, (int)b0_.w, (int)b1_.x, (int)b1_.y, (int)b1_.z, (int)b1_.w}, aw_ = (v8i32){(int)a0_.x, (int)a0_.y, (int)a0_.z, (int)a0_.w, (int)a1_.x, (int)a1_.y, (int)a1_.z, (int)a1_.w}; \
            acc[ai][bj][m][n] = __builtin_amdgcn_mfma_scale_f32_16x16x128_f8f6f4(bw_, aw_, acc[ai][bj][m][n], 0, 0, 0, W8_E8M0, 0, ONE_E8M0); } } \
        else { _Pragma("unroll") for (int m = 0; m < 4; ++m) _Pragma("unroll") for (int n = 0; n < 2; ++n) _Pragma("unroll") for (int k = 0; k < 2; ++k) \
            acc[ai][bj][m][n] = __builtin_amdgcn_mfma_f32_16x16x32_bf16(Bt[n][k], At[m][k], acc[ai][bj][m][n], 0, 0, 0); } \
        __builtin_amdgcn_s_setprio(0); } while (0)
#define G8_WAIT_V(n) asm volatile("s_waitcnt vmcnt(" #n ")" ::: "memory")
#define G8_WAIT_L(n) asm volatile("s_waitcnt lgkmcnt(" #n ")" ::: "memory")
#define G8_BAR __builtin_amdgcn_s_barrier()
#define G8_SCHED __builtin_amdgcn_sched_barrier(0)
    Unit cur, nxt; int ui = 0;
    if (!S.next(0, cur)) return;
    f32x4 acc[2][2][4][2];
    {
        f32x4 nb0[2][2];
        if constexpr (Epi::BIAS) { int t3_ = lane_id(); asm volatile("" : "+v"(t3_)); E.bias(cur, wc, t3_ >> 4, nb0); }
#pragma unroll
        for (int a = 0; a < 2; ++a)
#pragma unroll
            for (int b = 0; b < 2; ++b)
#pragma unroll
                for (int m = 0; m < 4; ++m)
#pragma unroll
                    for (int n = 0; n < 2; ++n) { if constexpr (Epi::BIAS) acc[a][b][m][n] = nb0[b][n]; else acc[a][b][m][n] = (f32x4){0.f, 0.f, 0.f, 0.f}; }
    }
    bf16x8 At[4][2], B0[2][2], B1[2][2];
    const char* cA = S.a_ptr(cur); const char* cB = S.b_ptr(cur);
    if constexpr (GATHER) {
        if (wid < 4) __builtin_amdgcn_global_load_lds((const unsigned*)(S.idx_ptr(cur) + wid * 64 + lane), (LAS unsigned*)(ldsidx + wid * 256), 4, 0, 0);
        G8_WAIT_V(0); G8_BAR;
        const LAS int* ix = (const LAS int*)ldsidx;
#pragma unroll
        for (int i = 0; i < 2; ++i) { int R, C; stage_rc(tid * 16 + i * 8192, R, C); cu[0][i] = (unsigned)(ix[R] * RP + C * 2); cu[1][i] = (unsigned)(ix[HALF + R] * RP + C * 2); }
        G8_WAIT_L(0); G8_BAR;
    }
    G8_STAGEB(G8_SB(0, 0), cB); G8_STAGEB(G8_SB(0, 1), cB + hstep); G8_STAGEA(G8_SA(0, 0), cA, 0); G8_STAGEA(G8_SA(0, 1), cA, 1);
    if (wr == 1) G8_BAR;
    G8_WAIT_V(2); G8_BAR;
    G8_STAGEB(G8_SB(1, 0), cB + kstep); G8_STAGEA(G8_SA(1, 0), cA + kstep, 0); G8_STAGEB(G8_SB(1, 1), cB + hstep + kstep);
    G8_WAIT_V(6); G8_BAR;
    for (;;) {
        const bool has_next = S.next(ui + 1, nxt);
        const char* nA = has_next ? S.a_ptr(nxt) : cA; const char* nB = has_next ? S.b_ptr(nxt) : cB;
        if constexpr (GATHER) {
            if (has_next && wid < 4) __builtin_amdgcn_global_load_lds((const unsigned*)(S.idx_ptr(nxt) + wid * 64 + lane), (LAS unsigned*)(ldsidx + ((ui + 1) & 1) * 1024 + wid * 256), 4, 0, 0);
        }
#pragma unroll 1
        for (int t = 0; t < nt; t += 2) {
            const bool last = (t == nt - 2);
            if constexpr (Epi::PREFETCH) { if (t == 2) E.prefetch(cur, lds + 131072, wid); }
            const char* a1 = cA + (size_t)(t + 1) * kstep;
            const char* a2 = last ? nA : cA + (size_t)(t + 2) * kstep; const char* b2 = last ? nB : cB + (size_t)(t + 2) * kstep;
            const char* a3 = a2 + kstep; const char* b3 = b2 + kstep;
            G8_LDB(B0, 0, 0); G8_LDB(B1, 0, 1); G8_SCHED; G8_LDA(At, 0, 0); G8_STAGEA(G8_SA(1, 1), a1, 1);
            G8_WAIT_V(8); G8_WAIT_L(0); G8_BAR; G8_MMA(0, 0, At, B0); G8_MMA(0, 1, At, B1); G8_BAR; G8_SCHED;
            if constexpr (GATHER) {
                if (last && has_next) { const LAS int* ix = (const LAS int*)(ldsidx + ((ui + 1) & 1) * 1024);
#pragma unroll
                    for (int i = 0; i < 2; ++i) { int R, C; stage_rc(tid * 16 + i * 8192, R, C); cu[0][i] = (unsigned)(ix[R] * RP + C * 2); cu[1][i] = (unsigned)(ix[HALF + R] * RP + C * 2); } }
            }
            G8_LDA(At, 0, 1); G8_STAGEB(G8_SB(0, 0), b2); G8_STAGEB(G8_SB(0, 1), b2 + hstep); G8_STAGEA(G8_SA(0, 0), a2, 0);
            G8_WAIT_V(8); G8_WAIT_L(0); G8_BAR; G8_MMA(1, 0, At, B0); G8_MMA(1, 1, At, B1); G8_BAR; G8_SCHED;
            G8_LDB(B0, 1, 0); G8_LDB(B1, 1, 1); G8_SCHED; G8_LDA(At, 1, 0); G8_STAGEA(G8_SA(0, 1), a2, 1);
            G8_WAIT_V(8); G8_WAIT_L(0); G8_BAR; G8_MMA(0, 0, At, B0); G8_MMA(0, 1, At, B1); G8_BAR; G8_SCHED;
            G8_LDA(At, 1, 1); G8_STAGEB(G8_SB(1, 0), b3); G8_STAGEB(G8_SB(1, 1), b3 + hstep); G8_STAGEA(G8_SA(1, 0), a3, 0);
            G8_WAIT_V(8); G8_WAIT_L(0); G8_BAR; G8_MMA(1, 0, At, B0); G8_MMA(1, 1, At, B1); G8_BAR; G8_SCHED;
        }
        if (wr == 0) G8_BAR;
        f32x4 nb[2][2];
        { int t2_ = lane_id(); asm volatile("" : "+v"(t2_));
          if constexpr (Epi::BIAS) E.bias(has_next ? nxt : cur, wc, t2_ >> 4, nb);
          E(acc, cur, wr, wc, t2_ & 15, t2_ >> 4); }
        if (!has_next) break;
#pragma unroll
        for (int a = 0; a < 2; ++a)
#pragma unroll
            for (int b = 0; b < 2; ++b)
#pragma unroll
                for (int m = 0; m < 4; ++m)
#pragma unroll
                    for (int n = 0; n < 2; ++n) { if constexpr (Epi::BIAS) acc[a][b][m][n] = nb[b][n]; else acc[a][b][m][n] = (f32x4){0.f, 0.f, 0.f, 0.f}; }
        cur = nxt; cA = nA; cB = nB; ++ui;
        if (wr == 1) G8_BAR;
    }
    G8_WAIT_V(0);
    G8_BAR;
#undef G8_SA
#undef G8_SB
#undef G8_STAGEA
#undef G8_STAGEA_
#undef G8_DMA
#undef G8_STAGEB
#undef G8_LDA
#undef G8_LDB
#undef G8_MMA
#undef G8_WAIT_V
#undef G8_WAIT_L
#undef G8_BAR
#undef G8_SCHED
}

struct DenseSched {
    const char* A; const char* B; int t0, t1, npn, x, k, gx;
    __device__ __forceinline__ bool next(int i, Unit& u) const {
        const int j = i * gx + k, q = j / npn, rt = t0 + x + 8 * q;
        if (rt >= t1) return false;
        u.rt = rt; u.pn = j - q * npn; u.e = 0; u.row0 = rt * BM; u.nvalid = BM;
        return true;
    }
    __device__ __forceinline__ const char* a_ptr(const Unit& u) const { return A + (size_t)u.rt * (BM * KDIM * 2); }
    __device__ __forceinline__ const char* b_ptr(const Unit& u) const { return B + (size_t)u.pn * (BM * KDIM * 2); }
    __device__ __forceinline__ const int* idx_ptr(const Unit&) const { return nullptr; }
};
}


struct EpiInProj {
    static constexpr bool PERM = true, PREFETCH = true, BIAS = false;
    unsigned char* ws; LAS unsigned char* xr;
    __device__ __forceinline__ void prefetch(const g8::Unit& u, LAS unsigned char* xbuf, int wid) const {
        const int lane = lane_id();
        const unsigned char* src = ws + WS_ROPE + (size_t)u.rt * (256 * 64);
#pragma unroll
        for (int i = 0; i < 2; ++i) { const int pc = wid + 8 * i, P = pc * 64 + lane, row = P >> 2, uu = P & 3;
            dma16(src + (size_t)(row * 4 + (uu ^ ((row >> 2) & 3))) * 16, xbuf + pc * 1024); }
    }
    template <bool GAIN, bool ROPE, int KMODE>
    __device__ __forceinline__ void body(const g8::f32x4 (&acc)[2][2][4][2], const g8::Unit& u, int wr, int fr, int fq, const float* gain, float scale, bf16_t* dst, int pitch) const {
        g8::f32x4 gv[2][2];
        if constexpr (GAIN) {
#pragma unroll
            for (int bj = 0; bj < 2; ++bj)
#pragma unroll
                for (int n = 0; n < 2; ++n) gv[bj][n] = *(const g8::f32x4*)(gain + 32 * bj + 8 * fq + 4 * n) * scale;
        }
#pragma unroll
        for (int ai = 0; ai < 2; ++ai)
#pragma unroll
            for (int m = 0; m < 4; ++m) {
                const int tok = 256 * u.rt + 128 * ai + 64 * wr + 16 * m + fr;
                g8::f32x4 y[2][2];
                if constexpr (GAIN) {
                    float ss = 0.f;
#pragma unroll
                    for (int bj = 0; bj < 2; ++bj)
#pragma unroll
                        for (int n = 0; n < 2; ++n) { const g8::f32x4 v = acc[ai][bj][m][n]; ss += (v[0] * v[0] + v[1] * v[1]) + (v[2] * v[2] + v[3] * v[3]); }
                    { const auto r_ = __builtin_amdgcn_permlane16_swap(__float_as_uint(ss), __float_as_uint(ss), false, false); ss = __uint_as_float(r_[0]) + __uint_as_float(r_[1]); }
                    { const auto r_ = __builtin_amdgcn_permlane32_swap(__float_as_uint(ss), __float_as_uint(ss), false, false); ss = __uint_as_float(r_[0]) + __uint_as_float(r_[1]); }
                    const float rinv = __builtin_amdgcn_rsqf(ss * (1.0f / 64.0f) + NORM_EPS);
#pragma unroll
                    for (int bj = 0; bj < 2; ++bj)
#pragma unroll
                        for (int n = 0; n < 2; ++n) y[bj][n] = acc[ai][bj][m][n] * rinv * gv[bj][n];
                } else {
#pragma unroll
                    for (int bj = 0; bj < 2; ++bj)
#pragma unroll
                        for (int n = 0; n < 2; ++n) y[bj][n] = acc[ai][bj][m][n];
                }
                if constexpr (ROPE) {
                    const int rowu = 128 * ai + 64 * wr + 16 * m + fr;
                    const LAS unsigned char* rbase = (fq < 2) ? xr + rowu * 64 : xr + 16384; const int sw = (fq < 2) ? (rowu >> 2) & 3 : 0;
                    const int uA = (fq & 1) ? 2 : 0, uB = 2 - uA; const unsigned sgnB = (fq == 0) ? 0x80000000u : 0u;
#pragma unroll
                    for (int n = 0; n < 2; ++n) {
                        const g8::f32x4 A4 = *(const LAS g8::f32x4*)(rbase + 16 * ((uA + n) ^ sw)), B4 = *(const LAS g8::f32x4*)(rbase + 16 * ((uB + n) ^ sw));
#pragma unroll
                        for (int e = 0; e < 4; ++e) {
                            const unsigned xm = __float_as_uint(y[0][n][e]);
                            const auto r_ = __builtin_amdgcn_permlane16_swap(xm, xm, false, false);
                            const float lo_ = __uint_as_float(r_[0]), hi_ = __uint_as_float(r_[1]), bs_ = __uint_as_float(__float_as_uint(B4[e]) ^ sgnB);
                            float t_;
                            asm("v_mul_f32 %0, %1, %2" : "=v"(t_) : "v"(hi_), "v"(bs_));
                            asm("v_fmac_f32 %0, %1, %2" : "+v"(t_) : "v"(lo_), "v"(A4[e]));
                            y[0][n][e] = t_;
                        }
                    }
                }
                const int bb = tok >> 11, ss_ = tok & 2047;
                bf16_t* drow; int bjstep;
                if constexpr (KMODE == 0) { drow = dst + (size_t)tok * pitch + 8 * fq; bjstep = 32; }
                else if constexpr (KMODE == 1) { drow = dst + (size_t)bb * 1048576 + (ss_ >> 6) * 4096 + fq * 512 + (ss_ & 63) * 8; bjstep = 2048; }
                else if constexpr (KMODE == 2) { drow = dst + (size_t)bb * 131072 + (ss_ >> 6) * 4096 + fq * 512 + (ss_ & 63) * 8; bjstep = 2048; }
                else { drow = dst + (size_t)bb * 131072 + (ss_ >> 5) * 2048 + fq * 256 + (ss_ & 31) * 8; bjstep = 1024; }
#pragma unroll
                for (int bj = 0; bj < 2; ++bj) {
                    u32x4 w; w.x = cvt_pk_bf16(y[bj][0][0], y[bj][0][1]); w.y = cvt_pk_bf16(y[bj][0][2], y[bj][0][3]);
                    w.z = cvt_pk_bf16(y[bj][1][0], y[bj][1][1]); w.w = cvt_pk_bf16(y[bj][1][2], y[bj][1][3]);
                    *(u32x4*)(drow + bjstep * bj) = w;
                }
                asm volatile("" ::: "memory");
            }
    }
    __device__ __forceinline__ void operator()(const g8::f32x4 (&acc)[2][2][4][2], const g8::Unit& u, int wr, int wc, int fr, int fq) const {
        asm volatile("" : "+v"(fr), "+v"(fq));
        const int g = 4 * u.pn + wc;
        if (g < 8) body<true, true, 0>(acc, u, wr, fr, fq, CF(ws, C_GQA), QSCALE, (bf16_t*)(ws + WS_QA) + g * 64, 512);
        else if (g < 16) body<false, true, 0>(acc, u, wr, fr, fq, nullptr, 1.0f, (bf16_t*)(ws + WS_QI) + (g - 8) * 64, 512);
        else if (g < 24) body<true, true, 0>(acc, u, wr, fr, fq, CF(ws, C_GQB), QSCALE, (bf16_t*)(ws + WS_QB) + (g - 16) * 64, 512);
        else if (g < 32) body<true, true, 1>(acc, u, wr, fr, fq, CF(ws, C_GKB), 1.0f, (bf16_t*)(ws + WS_KB) + (size_t)(g - 24) * 131072, 0);
        else if (g < 40) body<false, false, 0>(acc, u, wr, fr, fq, nullptr, 1.0f, (bf16_t*)(ws + WS_VBT) + (g - 32) * 64, 512);
        else if (g == 40) body<true, true, 2>(acc, u, wr, fr, fq, CF(ws, C_GKA), 1.0f, (bf16_t*)(ws + WS_KA), 0);
        else if (g == 41) body<false, false, 0>(acc, u, wr, fr, fq, nullptr, 1.0f, (bf16_t*)(ws + WS_VAT), 64);
        else if (g == 42) body<true, true, 3>(acc, u, wr, fr, fq, CF(ws, C_GIK), 1.0f, (bf16_t*)(ws + WS_KI), 0);
        else {
#pragma unroll
            for (int ai = 0; ai < 2; ++ai)
#pragma unroll
                for (int m = 0; m < 4; ++m) {
                    const int tok = 256 * u.rt + 128 * ai + 64 * wr + 16 * m + fr;
                    if (fq == 0) { float* wi = (float*)(ws + WS_WI) + (size_t)tok * 8; *(g8::f32x4*)wi = acc[ai][0][m][0] * IW_SCALE; *(g8::f32x4*)(wi + 4) = acc[ai][0][m][1] * IW_SCALE; }
                }
        }
    }
};
__device__ __forceinline__ void p1_inproj_g8(const Ctx& X, const Params& P, LAS unsigned char* ldsall) {
    g8::DenseSched S; S.A = (const char*)(P.ws + WS_H); S.B = (const char*)(P.ws + WS_WIN); S.t0 = 0; S.t1 = T_TOK / 256; S.npn = NGROUP / 4; S.x = X.mx; S.k = X.mk; S.gx = X.nwg >> 3;
    if (X.tid < 16) ((LAS float*)(ldsall + 4096 + 131072 + 16384))[X.tid] = X.tid < 8 ? 1.0f : 0.0f;
    __syncthreads();
    EpiInProj E{P.ws, ldsall + 4096 + 131072};
    g8::gemm_phase<EpiInProj, g8::DenseSched, false>(ldsall + 4096, ldsall + 2048, S, E, X.wid);
}

struct EpiOutProj {
    static constexpr bool PERM = true, PREFETCH = false, BIAS = false;
    const float* x; bf16_t* x1b;
    __device__ __forceinline__ void operator()(const g8::f32x4 (&acc)[2][2][4][2], const g8::Unit& u, int wr, int wc, int fr, int fq) const {
        asm volatile("" : "+v"(fr), "+v"(fq));
        const int row0 = u.rt * 256 + wr * 64 + fr, col0 = u.pn * 256 + wc * 32 + 8 * fq;
#pragma unroll
        for (int ai = 0; ai < 2; ++ai)
#pragma unroll
            for (int m = 0; m < 4; ++m) {
                const size_t ro = (size_t)(row0 + ai * 128 + m * 16) * DM + col0;
#pragma unroll
                for (int bj = 0; bj < 2; ++bj) {
                    const g8::f32x4 v0 = *(const g8::f32x4*)(x + ro + bj * 128) + acc[ai][bj][m][0], v1 = *(const g8::f32x4*)(x + ro + bj * 128 + 4) + acc[ai][bj][m][1];
                    u32x4 w; w.x = cvt_pk_bf16(v0[0], v0[1]); w.y = cvt_pk_bf16(v0[2], v0[3]); w.z = cvt_pk_bf16(v1[0], v1[1]); w.w = cvt_pk_bf16(v1[2], v1[3]);
                    *(u32x4*)(x1b + ro + bj * 128) = w;
                }
            }
    }
};
__device__ __forceinline__ void p3_outproj_g8(const Ctx& X, const Params& P, LAS unsigned char* ldsall) {
    g8::DenseSched S; S.A = (const char*)(P.ws + WS_H); S.B = (const char*)(P.ws + WS_WO); S.t0 = 0; S.t1 = T_TOK / 256; S.npn = 4; S.x = X.mx; S.k = X.mk; S.gx = X.nwg >> 3;
    EpiOutProj E{P.in[0], (bf16_t*)(P.ws + WS_X1B)};
    g8::gemm_phase<EpiOutProj, g8::DenseSched, false>(ldsall + 4096, ldsall + 2048, S, E, X.wid);
}

__device__ __forceinline__ void p4_router(const Ctx& X, const Params& P) {
    unsigned char* ws = P.ws;
    const bf16_t* x1b = (const bf16_t*)(ws + WS_X1B); const float* g = CF(ws, C_GFFN);
    const bf16_t* WR = (const bf16_t*)(ws + WS_WR);
    const float* brt = CF(ws, C_BRT);
    int* topk_e = (int*)(ws + WS_TOPK_E); float* topk_g = (float*)(ws + WS_TOPK_G); int* CNT = (int*)(ws + WS_CNT);
    const int c = X.c, h = X.h, lane = X.lane;
    LAS int* hist = (LAS int*)X.lds;
    for (int wgt = X.wg; wgt < T_TOK / 256; wgt += X.nwg) {
        if (X.tid < 32) hist[X.tid] = 0;
        __syncthreads();
        const int tok0 = wgt * 256 + X.wid * 32;
        f32x4 gv4[4];
#pragma unroll
        for (int i = 0; i < 2; ++i) { gv4[2 * i] = ((const f32x4*)g)[2 * (lane + 64 * i)]; gv4[2 * i + 1] = ((const f32x4*)g)[2 * (lane + 64 * i) + 1]; }
        float myrinv = 0.f;
        for (int r0 = 0; r0 < 32; r0 += 8) {
            u32x4 raw[8][2]; float ss[8];
#pragma unroll
            for (int r = 0; r < 8; ++r)
#pragma unroll
                for (int i = 0; i < 2; ++i) raw[r][i] = *((const u32x4*)(x1b + (size_t)(tok0 + r0 + r) * DM) + lane + 64 * i);
#pragma unroll
            for (int r = 0; r < 8; ++r) { float a = 0.f;
#pragma unroll
                for (int i = 0; i < 2; ++i)
#pragma unroll
                    for (int q = 0; q < 4; ++q) { const float lo = bf_lo(raw[r][i][q]), hi = bf_hi(raw[r][i][q]); a += lo * lo + hi * hi; }
                ss[r] = a; }
#pragma unroll
            for (int o = 32; o >= 1; o >>= 1)
#pragma unroll
                for (int r = 0; r < 8; ++r) ss[r] += __shfl_xor(ss[r], o);
#pragma unroll
            for (int r = 0; r < 8; ++r) {
                const int row = tok0 + r0 + r;
                const float rinv = 1.0f / sqrtf(ss[r] * (1.0f / DM) + NORM_EPS);
                if (c == r0 + r) myrinv = rinv;
#pragma unroll
                for (int i = 0; i < 2; ++i) {
                    float y[8];
#pragma unroll
                    for (int q = 0; q < 4; ++q) { y[2 * q] = bf_lo(raw[r][i][q]) * rinv * gv4[2 * i + (q >> 1)][2 * (q & 1)]; y[2 * q + 1] = bf_hi(raw[r][i][q]) * rinv * gv4[2 * i + (q >> 1)][2 * (q & 1) + 1]; }
                    u32x2 w; w.x = cvt4_fp8(y[0], y[1], y[2], y[3]); w.y = cvt4_fp8(y[4], y[5], y[6], y[7]);
                    *(u32x2*)(ws + WS_H2F8 + (size_t)row * DM + 8 * (lane + 64 * i)) = w;
                }
            }
        }
        f32x16 L = zero16();
        {
            const bf16_t* ap = WR + (size_t)c * DM + 8 * h;
            const bf16_t* bp = x1b + (size_t)(tok0 + c) * DM + 8 * h;
#pragma unroll 4
            for (int k0 = 0; k0 < DM; k0 += 16) {
                const u32x4 raw = *(const u32x4*)(bp + k0);
                L = MFMA32(ldfrag(ap + k0), __builtin_bit_cast(bf16x8, raw), L);
            }
        }
#pragma unroll
        for (int r = 0; r < 16; ++r) L[r] *= myrinv;
        float own[16], oth[16];
#pragma unroll
        for (int r = 0; r < 16; ++r) { own[r] = L[r] + brt[crow(r, h)]; }
#pragma unroll
        for (int r = 0; r < 16; ++r) oth[r] = __shfl_xor(own[r], 32);
        float tv[4]; int te[4];
#pragma unroll
        for (int k = 0; k < 4; ++k) {
            float best = -INFINITY; int bid = 1 << 20;
#pragma unroll
            for (int r = 0; r < 16; ++r) {
                const int e0 = crow(r, h), e1 = crow(r, 1 - h);
                if (own[r] > best || (own[r] == best && e0 < bid)) { best = own[r]; bid = e0; }
                if (oth[r] > best || (oth[r] == best && e1 < bid)) { best = oth[r]; bid = e1; }
            }
            tv[k] = best; te[k] = min(max(bid, 0), 31);
#pragma unroll
            for (int r = 0; r < 16; ++r) { if (crow(r, h) == bid) own[r] = -INFINITY; if (crow(r, 1 - h) == bid) oth[r] = -INFINITY; }
        }
        if (h == 0) {
            const float e0 = 1.0f, e1 = expf(tv[1] - tv[0]), e2 = expf(tv[2] - tv[0]), e3 = expf(tv[3] - tv[0]);
            const float inv = 1.0f / (e0 + e1 + e2 + e3);
            const int tok = tok0 + c;
            *(int4*)(topk_e + (size_t)tok * 4) = make_int4(te[0], te[1], te[2], te[3]);
            f32x4 gg; gg[0] = e0 * inv; gg[1] = e1 * inv; gg[2] = e2 * inv; gg[3] = e3 * inv;
            *(f32x4*)(topk_g + (size_t)tok * 4) = gg;
#pragma unroll
            for (int k = 0; k < 4; ++k) atomicAdd((int*)&hist[te[k]], 1);
        }
        __syncthreads();
        if (X.tid < 32) CNT[wgt * 32 + X.tid] = hist[X.tid];
        __syncthreads();
    }
}

__device__ __forceinline__ void p5_slots(const Ctx& X, const Params& P) {
    unsigned char* ws = P.ws;
    const int* CNT = (const int*)(ws + WS_CNT); int* EXPS = (int*)(ws + WS_EXP);
    const int* topk_e = (const int*)(ws + WS_TOPK_E); int* tokslot = (int*)(ws + WS_TOKSLOT); int* slottok = (int*)(ws + WS_SLOTTOK);
    LAS int* tot = (LAS int*)X.lds;
    LAS int* base = (LAS int*)X.lds + 32;
    LAS int* start = (LAS int*)X.lds + 64;
    LAS int* cur = (LAS int*)X.lds + 128;
    for (int wgt = X.wg; wgt < T_TOK / 256; wgt += X.nwg) {
        __syncthreads();
        {
            LAS int* ptot = (LAS int*)X.lds + 256; LAS int* pbase = (LAS int*)X.lds + 768;
            const int e = X.tid & 31, part = X.tid >> 5;
            int t = 0, bs = 0;
#pragma unroll
            for (int i = 0; i < 16; ++i) { const int w = part * 16 + i; const int v = CNT[w * 32 + e]; t += v; bs += (w < wgt) ? v : 0; }
            ptot[part * 32 + e] = t; pbase[part * 32 + e] = bs;
            __syncthreads();
            if (X.tid < 32) { int tt = 0, bb = 0;
#pragma unroll
                for (int q = 0; q < 16; ++q) { tt += ptot[q * 32 + X.tid]; bb += pbase[q * 32 + X.tid]; }
                tot[X.tid] = tt; base[X.tid] = bb; cur[X.tid] = 0; }
        }
        __syncthreads();
        if (X.tid == 0) { int s = 0; for (int e = 0; e < 32; ++e) { start[e] = s; s += tot[e]; } start[32] = s; }
        __syncthreads();
        if (wgt == 0) {
            if (X.tid < 33) EXPS[X.tid] = start[X.tid];
            if (X.tid < 256) slottok[NSLOT + X.tid] = 0;
        }
        if (X.tid < 256) {
            const int tok = wgt * 256 + X.tid;
            const int4 e4 = *(const int4*)(topk_e + (size_t)tok * 4);
            const int es[4] = {e4.x, e4.y, e4.z, e4.w};
            int sl[4];
#pragma unroll
            for (int k = 0; k < 4; ++k) { const int e = min(max(es[k], 0), 31); const int pos = atomicAdd((int*)&cur[e], 1); sl[k] = min(max(start[e] + base[e] + pos, 0), NSLOT - 1); slottok[sl[k]] = tok; }
            *(int4*)(tokslot + (size_t)tok * 4) = make_int4(sl[0], sl[1], sl[2], sl[3]);
        }
    }
}

constexpr size_t WS_ACT = MIB(208);
template <bool GATHER, int NPN, int PITCH, int BROWS>
struct MoeSched {
    const LAS int* desc;
    const char* A; const char* B; const int* slottok; int t1, x, k, gx;
    __device__ __forceinline__ bool next(int i, g8::Unit& u) const {
        const int j = i * gx + k, q = j / NPN, rt = x + 8 * q;
        if (rt >= t1) return false;
        const int row0 = __builtin_amdgcn_readfirstlane(desc[2 * rt]), info = __builtin_amdgcn_readfirstlane(desc[2 * rt + 1]);
        u.rt = rt; u.pn = j - q * NPN; u.e = info >> 16; u.row0 = row0; u.nvalid = info & 0xffff;
        return true;
    }
    __device__ __forceinline__ const char* a_ptr(const g8::Unit& u) const { return GATHER ? A : A + (size_t)u.row0 * PITCH; }
    __device__ __forceinline__ const char* b_ptr(const g8::Unit& u) const { return B + ((size_t)u.e * BROWS + (size_t)u.pn * 256) * PITCH; }
    __device__ __forceinline__ const int* idx_ptr(const g8::Unit& u) const { return slottok + u.row0; }
};
struct EpiGU {
    static constexpr bool PERM = true, PREFETCH = false, BIAS = true;
    const float* bgu; unsigned char* act; int rb;
    __device__ __forceinline__ void bias(const g8::Unit& u, int wc, int fq, g8::f32x4 (&nb)[2][2]) const {
        const int colbase = 128 * u.pn + 32 * wc + 8 * fq;
#pragma unroll
        for (int n = 0; n < 2; ++n) { nb[0][n] = *(const g8::f32x4*)(bgu + (size_t)u.e * 2048 + colbase + 4 * n); nb[1][n] = *(const g8::f32x4*)(bgu + (size_t)u.e * 2048 + 1024 + colbase + 4 * n) + 1.0f; }
    }
    __device__ __forceinline__ void operator()(const g8::f32x4 (&acc)[2][2][4][2], const g8::Unit& u, int wr, int wc, int fr, int fq) const {
        asm volatile("" : "+v"(fr), "+v"(fq));
        const int colst = 128 * u.pn + 32 * wc + 8 * (fq & ~1);
#pragma unroll
        for (int ai = 0; ai < 2; ++ai)
#pragma unroll
            for (int mp = 0; mp < 4; mp += 2) {
                u32x2 w[2];
#pragma unroll
                for (int q2 = 0; q2 < 2; ++q2) {
                    const int m = mp + q2;
                    float a[8];
                    typedef float f32x2e __attribute__((ext_vector_type(2)));
#pragma unroll
                    for (int n = 0; n < 2; ++n)
#pragma unroll
                        for (int q = 0; q < 4; q += 2) {
                            f32x2e g2 = (f32x2e){acc[ai][0][m][n][q], acc[ai][0][m][n][q + 1]};
                            g2[0] = __builtin_amdgcn_fmed3f(g2[0], -3.0e38f, 7.0f); g2[1] = __builtin_amdgcn_fmed3f(g2[1], -3.0e38f, 7.0f);
                            f32x2e l2 = (f32x2e){acc[ai][1][m][n][q], acc[ai][1][m][n][q + 1]};
                            l2[0] = __builtin_amdgcn_fmed3f(l2[0], -6.0f, 8.0f); l2[1] = __builtin_amdgcn_fmed3f(l2[1], -6.0f, 8.0f);
                            const f32x2e t2 = g2 * -2.4554669595930157f;
                            f32x2e d2 = (f32x2e){__builtin_amdgcn_exp2f(t2[0]), __builtin_amdgcn_exp2f(t2[1])} + 1.0f;
                            const f32x2e s2 = (f32x2e){__builtin_amdgcn_rcpf(d2[0]), __builtin_amdgcn_rcpf(d2[1])};
                            const f32x2e a2 = g2 * s2 * l2;
                            a[4 * n + q] = a2[0]; a[4 * n + q + 1] = a2[1];
                        }
                    w[q2].x = cvt4_fp8(a[0], a[1], a[2], a[3]); w[q2].y = cvt4_fp8(a[4], a[5], a[6], a[7]);
                }
                const auto rx = __builtin_amdgcn_permlane16_swap(w[0].x, w[1].x, false, false), ry = __builtin_amdgcn_permlane16_swap(w[0].y, w[1].y, false, false);
                const int r = 128 * ai + 64 * wr + 16 * (mp + (fq & 1)) + fr;
                if (r < u.nvalid) *(u32x4*)(act + (size_t)(u.row0 - rb + r) * DEXP + colst) = (u32x4){(unsigned)rx[0], (unsigned)ry[0], (unsigned)rx[1], (unsigned)ry[1]};
                asm volatile("" ::: "memory");
            }
    }
};
struct EpiDown {
    static constexpr bool PERM = true, PREFETCH = false, BIAS = true;
    const float* bdn; unsigned char* ys;
    __device__ __forceinline__ void bias(const g8::Unit& u, int wc, int fq, g8::f32x4 (&nb)[2][2]) const {
        const int colbase = 256 * u.pn + 32 * wc + 8 * fq;
#pragma unroll
        for (int bj = 0; bj < 2; ++bj)
#pragma unroll
            for (int n = 0; n < 2; ++n) nb[bj][n] = *(const g8::f32x4*)(bdn + (size_t)u.e * 1024 + colbase + 128 * bj + 4 * n);
    }
    __device__ __forceinline__ void operator()(const g8::f32x4 (&acc)[2][2][4][2], const g8::Unit& u, int wr, int wc, int fr, int fq) const {
        asm volatile("" : "+v"(fr), "+v"(fq));
        const int colst = 256 * u.pn + 32 * wc + 8 * (fq & ~1);
#pragma unroll
        for (int bj = 0; bj < 2; ++bj) {
#pragma unroll
            for (int ai = 0; ai < 2; ++ai)
#pragma unroll
                for (int mp = 0; mp < 4; mp += 2) {
                    u32x2 w[2];
#pragma unroll
                    for (int q2 = 0; q2 < 2; ++q2) { const g8::f32x4 v0 = acc[ai][bj][mp + q2][0], v1 = acc[ai][bj][mp + q2][1];
                        w[q2].x = cvt4_fp8(v0[0], v0[1], v0[2], v0[3]); w[q2].y = cvt4_fp8(v1[0], v1[1], v1[2], v1[3]); }
                    const auto rx = __builtin_amdgcn_permlane16_swap(w[0].x, w[1].x, false, false), ry = __builtin_amdgcn_permlane16_swap(w[0].y, w[1].y, false, false);
                    const int r = 128 * ai + 64 * wr + 16 * (mp + (fq & 1)) + fr;
                    if (r < u.nvalid) *(u32x4*)(ys + (size_t)(u.row0 + r) * DM + colst + 128 * bj) = (u32x4){(unsigned)rx[0], (unsigned)ry[0], (unsigned)rx[1], (unsigned)ry[1]};
                }
            asm volatile("" ::: "memory");
        }
    }
};
constexpr int LDS_TDESC = 4096 + 131072;
#define P6_ROUNDS(X, P, ldsall, bar) do { \
    unsigned char* ws_ = (P).ws; \
    LAS int* es_ = (LAS int*)((ldsall) + 64); LAS int* tp_ = (LAS int*)((ldsall) + 256); LAS int* desc_ = (LAS int*)((ldsall) + LDS_TDESC); \
    __syncthreads(); \
    if ((X).tid < 33) es_[(X).tid] = min(max(((const int*)(ws_ + WS_EXP))[(X).tid], 0), NSLOT); \
    __syncthreads(); \
    if ((X).tid == 0) { int s_ = 0; for (int e_ = 0; e_ < 32; ++e_) { tp_[e_] = s_; s_ += max(es_[e_ + 1] - es_[e_] + 255, 0) >> 8; } tp_[32] = s_; } \
    __syncthreads(); \
    const int ntile_ = min(tp_[32], 1056); \
    for (int t_ = (X).tid; t_ < ntile_; t_ += 512) { int e_ = 0; for (int kk_ = 1; kk_ < 32; ++kk_) if (tp_[kk_] <= t_) e_ = kk_; \
        const int row0_ = es_[e_] + 256 * (t_ - tp_[e_]); desc_[2 * t_] = row0_; desc_[2 * t_ + 1] = (e_ << 16) | min(256, es_[e_ + 1] - row0_); } \
    __syncthreads(); \
    { \
        { MoeSched<true, 8, 1024, 2048> S_; S_.desc = desc_; S_.slottok = (const int*)(ws_ + WS_SLOTTOK); S_.t1 = ntile_; S_.x = (X).mx; S_.k = (X).mk; S_.gx = (X).nwg >> 3; \
          S_.A = (const char*)(ws_ + WS_H2F8); S_.B = (const char*)(ws_ + WS_WGU); \
          EpiGU E_{CF(ws_, C_BGU), ws_ + WS_ACT, 0}; g8::gemm_phase<EpiGU, MoeSched<true, 8, 1024, 2048>, true, true>((ldsall) + 4096, (ldsall) + 2048, S_, E_, (X).wid); } \
        xcd_barrier(bar); \
        { MoeSched<false, 4, 1024, 1024> S_; S_.desc = desc_; S_.slottok = nullptr; S_.t1 = ntile_; S_.x = (X).mx; S_.k = (X).mk; S_.gx = (X).nwg >> 3; \
          S_.A = (const char*)(ws_ + WS_ACT); S_.B = (const char*)(ws_ + WS_WD); \
          EpiDown E_{CF(ws_, C_BDN), ws_ + WS_YS}; g8::gemm_phase<EpiDown, MoeSched<false, 4, 1024, 1024>, false, true>((ldsall) + 4096, (ldsall) + 2048, S_, E_, (X).wid); } \
        xcd_barrier(bar); \
    } } while (0)

__device__ __forceinline__ void p7_combine(const Ctx& X, const Params& P) {
    unsigned char* ws = P.ws;
    const int* tokslot = (const int*)(ws + WS_TOKSLOT); const float* topk_g = (const float*)(ws + WS_TOPK_G); const unsigned char* YS = ws + WS_YS;
    float* out = P.out; const bf16_t* x1b = (const bf16_t*)(ws + WS_X1B);
    typedef float f32x2v __attribute__((ext_vector_type(2)));
    int4 sl_n = *(const int4*)(tokslot + (size_t)min(X.gw, T_TOK - 1) * 4); f32x4 gg_n = *(const f32x4*)(topk_g + (size_t)min(X.gw, T_TOK - 1) * 4);
    for (int tok = X.gw; tok < T_TOK; tok += X.nw) {
        const int4 sl = sl_n; const f32x4 gg = gg_n;
        { const int tn = min(tok + X.nw, T_TOK - 1); sl_n = *(const int4*)(tokslot + (size_t)tn * 4); gg_n = *(const f32x4*)(topk_g + (size_t)tn * 4); }
        const int s4[4] = {min(max(sl.x, 0), NSLOT - 1), min(max(sl.y, 0), NSLOT - 1), min(max(sl.z, 0), NSLOT - 1), min(max(sl.w, 0), NSLOT - 1)};
#pragma unroll
        for (int half = 0; half < 2; ++half) {
            const int col = half * 512 + X.lane * 8;
            const u32x4 xw = __builtin_nontemporal_load((const u32x4*)(x1b + (size_t)tok * DM + col));
            f32x4 o0, o1; o0[0] = bf_lo(xw.x); o0[1] = bf_hi(xw.x); o0[2] = bf_lo(xw.y); o0[3] = bf_hi(xw.y); o1[0] = bf_lo(xw.z); o1[1] = bf_hi(xw.z); o1[2] = bf_lo(xw.w); o1[3] = bf_hi(xw.w);
#pragma unroll
            for (int k = 0; k < 4; ++k) {
                const u32x2 y = __builtin_nontemporal_load((const u32x2*)(YS + (size_t)s4[k] * DM + col)); const float gk = gg[k];
                const f32x2v a = __builtin_amdgcn_cvt_pk_f32_fp8((int)y.x, false), b = __builtin_amdgcn_cvt_pk_f32_fp8((int)y.x, true);
                const f32x2v c = __builtin_amdgcn_cvt_pk_f32_fp8((int)y.y, false), d = __builtin_amdgcn_cvt_pk_f32_fp8((int)y.y, true);
                o0[0] += gk * a[0]; o0[1] += gk * a[1]; o0[2] += gk * b[0]; o0[3] += gk * b[1];
                o1[0] += gk * c[0]; o1[1] += gk * c[1]; o1[2] += gk * d[0]; o1[3] += gk * d[1];
            }
            __builtin_nontemporal_store(o0, (f32x4*)(out + (size_t)tok * DM + col)); __builtin_nontemporal_store(o1, (f32x4*)(out + (size_t)tok * DM + col + 4));
        }
    }
}

constexpr int LDS_BYTES = 155648;
__global__ void __launch_bounds__(512, 2) fwd(Params P) {
    extern __shared__ __attribute__((aligned(16))) unsigned char lds[];
    const int wid0_ = __builtin_amdgcn_readfirstlane((int)threadIdx.x >> 6);
    if (threadIdx.x == 0) *(LAS u32x4*)lds = (u32x4){0u, 0u, 0u, 0u};
    __syncthreads();
    (void)xcd_barrier_post((unsigned*)(P.ws + WS_BAR), (volatile LAS unsigned*)lds, threadIdx.x == 0);
    if (threadIdx.x == 0) { const unsigned xc = xb_xcc_id(); ((LAS unsigned*)lds)[4] = xc; ((LAS unsigned*)lds)[5] = xb_add((unsigned*)(P.ws + WS_XRANK) + 64 * xc, 1u); }
#define xcd_barrier(b) xcd_barrier_((b), wid0_ == 0 && lane_id() == 0)
#define bar (XcdBarrier{(unsigned*)(P.ws + WS_BAR), xb_xcc_id(), (volatile LAS unsigned*)lds})
    Ctx X;
#define NEW_CTX() do { int l_ = lane_id(); asm volatile("" : "+v"(l_));     \
    X.lane = l_; X.wid = wid0_; X.tid = wid0_ * 64 + l_; X.c = X.lane & 31; X.h = X.lane >> 5; \
    X.wg = blockIdx.x; X.nwg = gridDim.x; X.gw = X.wg * 8 + X.wid; X.nw = X.nwg * 8; X.lds = (LAS unsigned char*)lds + 64; \
    { const LAS unsigned* m_ = (const LAS unsigned*)lds; const bool hw_ = (m_[2] != 0u) && (m_[4] < 8u) && (m_[5] < m_[0]);     \
      X.mx = __builtin_amdgcn_readfirstlane(hw_ ? (int)m_[4] : (X.wg & 7)); X.mk = __builtin_amdgcn_readfirstlane(hw_ ? (int)m_[5] : (X.wg >> 3)); } } while (0)

    NEW_CTX();
    p0_prologue(X, P);
    xcd_barrier(bar);
    NEW_CTX();
    p1_inproj_g8(X, P, (LAS unsigned char*)lds);
    xcd_barrier(bar);
    NEW_CTX();
    p2_mixers(X, P, (LAS unsigned char*)lds);
    xcd_barrier(bar);
    NEW_CTX();
    p3_outproj_g8(X, P, (LAS unsigned char*)lds);
    xcd_barrier(bar);
    NEW_CTX();
    p4_router(X, P);
    xcd_barrier(bar);
    NEW_CTX();
    p5_slots(X, P);
    xcd_barrier(bar);
    NEW_CTX();
    P6_ROUNDS(X, P, (LAS unsigned char*)lds, bar);
    NEW_CTX();
    p7_combine(X, P);
}

extern "C" void kernel_launch(void* const* d_in, const int* in_sizes, int n_in, void* d_out, int out_size, void* d_ws, size_t ws_size, hipStream_t stream) {
    static int grid = 0;
    if (grid == 0) {
        if (n_in != 22 || out_size != T_TOK * DM || ws_size < WS_END) { fprintf(stderr, "kernel_launch: unexpected shapes (n_in %d out %d ws %zu)\n", n_in, out_size, ws_size); grid = -1; return; }
        int dev = 0, cus = 0, per_cu = 0;
        if (hipGetDevice(&dev) != hipSuccess || hipDeviceGetAttribute(&cus, hipDeviceAttributeMultiprocessorCount, dev) != hipSuccess) { grid = -1; return; }
        if (hipFuncSetAttribute((const void*)fwd, hipFuncAttributeMaxDynamicSharedMemorySize, LDS_BYTES) != hipSuccess) { fprintf(stderr, "kernel_launch: hipFuncSetAttribute failed\n"); grid = -1; return; }
        if (hipOccupancyMaxActiveBlocksPerMultiprocessor(&per_cu, (const void*)fwd, 512, LDS_BYTES) != hipSuccess || per_cu < 1) { fprintf(stderr, "kernel_launch: occupancy query says %d\n", per_cu); }
        (void)hipGetLastError();
        grid = cus;
    }
    if (grid < 0) return;
    (void)hipMemsetAsync(d_ws, 0, 24576, stream);
    Params p{};
    for (int i = 0; i < 22; ++i) p.in[i] = (const float*)d_in[i];
    p.out = (float*)d_out; p.ws = (unsigned char*)d_ws;
    hipLaunchKernelGGL(fwd, dim3(grid), dim3(512), LDS_BYTES, stream, p);
}
```

```cpp
#include <hip/hip_runtime.h>
#include <stdint.h>
#include <stdio.h>

typedef unsigned short bf16_t;
typedef short bf16x8 __attribute__((ext_vector_type(8)));
typedef short s16x4 __attribute__((ext_vector_type(4)));
typedef float f32x16 __attribute__((ext_vector_type(16)));
typedef float f32x4 __attribute__((ext_vector_type(4)));
typedef unsigned u32x4 __attribute__((ext_vector_type(4)));
typedef unsigned u32x2 __attribute__((ext_vector_type(2)));

constexpr int T_TOK = 65536, DM = 1024, SEQ = 2048, NBATCH = 32;
constexpr int NGROUP = 44;
constexpr int NEXP = 32, DEXP = 1024;
constexpr int NSLOT = T_TOK * 4;
constexpr float NORM_EPS = 1e-6f;
constexpr float QSCALE = 0.125f * 1.4426950408889634f;
constexpr float IW_SCALE = 0.04419417382415922f;
constexpr float LAM_INIT = 0.2f;

#define MIB(x) ((size_t)(x) << 20)
constexpr size_t WS_BAR = 0;
constexpr size_t WS_XRANK = 16384;
constexpr size_t WS_CNT = 65536;
constexpr size_t WS_EXP = 65536 + 32768;
constexpr size_t WS_CONST = 524288;
constexpr int C_BGU = 0, C_BDN = 65536, C_GQA = 98304, C_GKA = C_GQA + 64, C_GIK = C_GQA + 128, C_LQ1 = C_GQA + 192, C_LK1 = C_GQA + 256, C_LQ2 = C_GQA + 320,
              C_LK2 = C_GQA + 384, C_GQB = C_GQA + 448, C_GKB = C_GQA + 512, C_GSUB = C_GQA + 576, C_GFFN = C_GQA + 704, C_BRT = C_GQA + 1728, C_END = C_GQA + 1760;
constexpr size_t WS_TOPK_E = MIB(1);
constexpr size_t WS_TOPK_G = MIB(2);
constexpr size_t WS_TOKSLOT = MIB(3);
constexpr size_t WS_ROPE = MIB(4);
constexpr size_t WS_SLOTTOK = MIB(4);
constexpr size_t WS_WGU = MIB(8);
constexpr size_t WS_WD = MIB(72);
constexpr size_t WS_H2F8 = MIB(104);
constexpr size_t WS_WIN = MIB(200);
constexpr size_t WS_WR = MIB(200) + 5767168;
constexpr size_t WS_WO = MIB(206);
constexpr size_t WS_H = MIB(208);
constexpr size_t WS_QA = MIB(336);
constexpr size_t WS_QI = MIB(400);
constexpr size_t WS_QB = MIB(464);
constexpr size_t WS_KB = MIB(528);
constexpr size_t WS_VBT = MIB(592);
constexpr size_t WS_KA = MIB(656);
constexpr size_t WS_VAT = MIB(664);
constexpr size_t WS_KI = MIB(672);
constexpr size_t WS_WI = MIB(680);
constexpr size_t WS_YS = MIB(512);
constexpr size_t WS_X1B = MIB(768);
constexpr size_t WS_END = MIB(1024);

#define XB_TMO      128
#define XB_XCNT(j)  (256  + 64 * (j))
#define XB_XSUB(j)  (1280 + 64 * (j))
#define XB_XGEN(j)  (2304 + 64 * (j))
#define XB_TOP      3328
#define XB_TOPGEN   3392
#define XCD_BAR_WORDS 3456
#define XB_SPIN_CAP (1u << 18)
#define LAS __attribute__((address_space(3)))

__device__ __forceinline__ unsigned xb_ld(unsigned* p)              { return __hip_atomic_load(p, __ATOMIC_RELAXED, __HIP_MEMORY_SCOPE_AGENT); }
__device__ __forceinline__ unsigned xb_add(unsigned* p, unsigned v) { return __hip_atomic_fetch_add(p, v, __ATOMIC_RELAXED, __HIP_MEMORY_SCOPE_AGENT); }
__device__ __forceinline__ unsigned xb_xcc_id() { return (unsigned)__builtin_amdgcn_s_getreg((3 << 11) | 20) & 0xFu; }
#define XB_SPIN(cond, bar) do { unsigned _sp = 0; while (cond) { __builtin_amdgcn_s_sleep(1); \
    if ((++_sp & 255u) == 0u) { if (xb_ld(&(bar)[XB_TMO])) break; if (_sp > XB_SPIN_CAP) { atomicAdd(&(bar)[XB_TMO], 1u); break; } } } } while (0)

struct XcdBarrier { unsigned* bar; unsigned x; volatile LAS unsigned* st; };

__device__ __forceinline__ XcdBarrier xcd_barrier_post(unsigned* bar, volatile LAS unsigned* st, bool t0  ) {
    XcdBarrier b; b.bar = bar; b.x = xb_xcc_id(); b.st = st;
    if (t0) (void)xb_add(&bar[XB_XCNT(b.x)], 1u);
    return b;
}
__device__ __forceinline__ bool xcd_barrier_complete(unsigned* bar, unsigned x, unsigned& nloc, unsigned& nx) {
    const unsigned G = gridDim.x * gridDim.y * gridDim.z;
    unsigned sum, cnt, mine, sp = 0u; bool uni;
    for (;;) {
        sum = 0u; cnt = 0u; mine = 0u; uni = true;
#pragma unroll
        for (unsigned j = 0; j < 16; ++j) { const unsigned c = xb_ld(&bar[XB_XCNT(j)]); sum += c; cnt += (c > 0u) ? 1u : 0u; mine = (j == x) ? c : mine; uni = uni && (c == 0u || c * 8u == G); }
        if (sum == G) break;
        __builtin_amdgcn_s_sleep(1);
        if ((++sp & 255u) == 0u) { if (xb_ld(&bar[XB_TMO])) break; if (sp > XB_SPIN_CAP) { atomicAdd(&bar[XB_TMO], 1u); break; } }
    }
    nloc = mine > 0u ? mine : 1u; nx = cnt > 0u ? cnt : 1u;
    return sum == G && cnt == 8u && uni;
}
__device__ __forceinline__ void xcd_barrier_(const XcdBarrier& b, bool t0  ) {
    asm volatile("s_waitcnt vmcnt(0)" ::: "memory");
    __syncthreads();
    if (t0) {
        unsigned* bar = b.bar;
        __builtin_amdgcn_s_waitcnt(0);
        unsigned nloc = b.st[0], nx = b.st[1];
        if (nloc == 0u) { const bool uni = xcd_barrier_complete(bar, b.x, nloc, nx); b.st[0] = nloc; b.st[1] = nx; b.st[2] = uni ? 1u : 0u; }
        const unsigned old = xb_add(&bar[XB_XSUB(b.x)], 1u);
        const unsigned gen = old / nloc;
        if (old + 1u == (gen + 1u) * nloc) {
            __builtin_amdgcn_fence(__ATOMIC_RELEASE, "agent");
            asm volatile("s_waitcnt vmcnt(0)" ::: "memory");
            const unsigned og = xb_add(&bar[XB_TOP], 1u);
            const unsigned tg = og / nx;
            if (og + 1u == (tg + 1u) * nx) xb_add(&bar[XB_TOPGEN], 1u);
            else XB_SPIN(xb_ld(&bar[XB_TOPGEN]) == tg, bar);
            __builtin_amdgcn_fence(__ATOMIC_ACQUIRE, "agent");
            xb_add(&bar[XB_XGEN(b.x)], 1u);
            asm volatile("s_waitcnt vmcnt(0)" ::: "memory");
        } else {
            XB_SPIN(xb_ld(&bar[XB_XGEN(b.x)]) == gen, bar);
            __builtin_amdgcn_fence(__ATOMIC_ACQUIRE, "agent");
            asm volatile("s_waitcnt vmcnt(0)" ::: "memory");
        }
    }
    __syncthreads();
}

#define MFMA32(a, b, c) __builtin_amdgcn_mfma_f32_32x32x16_bf16((a), (b), (c), 0, 0, 0)
__device__ __forceinline__ int crow(int r, int h) { return (r & 3) + 8 * (r >> 2) + 4 * h; }
typedef __bf16 bf16x2_t __attribute__((ext_vector_type(2)));
typedef float f32x2_t __attribute__((ext_vector_type(2)));
__device__ __forceinline__ unsigned cvt_pk_bf16(float lo, float hi) { f32x2_t v; v.x = lo; v.y = hi; return __builtin_bit_cast(unsigned, __builtin_convertvector(v, bf16x2_t)); }

typedef int v8i32 __attribute__((ext_vector_type(8)));
constexpr float W8_SCALE = 32.0f;
constexpr int W8_E8M0 = 127 - 5, ONE_E8M0 = 127;
__device__ __forceinline__ unsigned cvt4_fp8(float a, float b, float c, float d) { int w = __builtin_amdgcn_cvt_pk_fp8_f32(a, b, 0, false); w = __builtin_amdgcn_cvt_pk_fp8_f32(c, d, w, true); return (unsigned)w; }
__device__ __forceinline__ float wave_sum(float v) {
#pragma unroll
    for (int o = 32; o >= 1; o >>= 1) v += __shfl_xor(v, o);
    return v;
}
__device__ __forceinline__ bf16x8 ldfrag(const bf16_t* p) { return *reinterpret_cast<const bf16x8*>(p); }
__device__ __forceinline__ bf16x8 pack8(const f32x16& v, int base) {
    u32x4 w; w.x = cvt_pk_bf16(v[base + 0], v[base + 1]); w.y = cvt_pk_bf16(v[base + 2], v[base + 3]);
    w.z = cvt_pk_bf16(v[base + 4], v[base + 5]); w.w = cvt_pk_bf16(v[base + 6], v[base + 7]);
    return __builtin_bit_cast(bf16x8, w);
}
__device__ __forceinline__ f32x16 zero16() { f32x16 z;
#pragma unroll
    for (int i = 0; i < 16; ++i) z[i] = 0.f; return z; }


struct Params {
    const float* in[22];
    float* out;
    unsigned char* ws;
};

#define CF(ws, off) ((const float*)((ws) + WS_CONST) + (off))

__device__ __forceinline__ int lane_id() { unsigned z = 0; asm volatile("" : "+v"(z));
    return (int)__builtin_amdgcn_mbcnt_hi(~0u, __builtin_amdgcn_mbcnt_lo(~0u, z)); }

__device__ __forceinline__ float bf_lo(unsigned w) { return __uint_as_float(w << 16); }
__device__ __forceinline__ float bf_hi(unsigned w) { return __uint_as_float(w & 0xffff0000u); }
struct Ctx {
    int tid, lane, wid, c, h, gw, nw, wg, nwg, mx, mk;
    LAS unsigned char* lds;
};

__device__ __forceinline__ void p0_rmsnorm_rows(const Ctx& X, const float* __restrict__ x, const float* __restrict__ g, bf16_t* __restrict__ H) {
    f32x4 gv[4];
#pragma unroll
    for (int i = 0; i < 4; ++i) gv[i] = ((const f32x4*)g)[X.lane + 64 * i];
    for (int base = X.gw * 4; base < T_TOK; base += X.nw * 4) {
        f32x4 v[4][4]; float ss[4];
#pragma unroll
        for (int r = 0; r < 4; ++r)
#pragma unroll
            for (int i = 0; i < 4; ++i) v[r][i] = __builtin_nontemporal_load((const f32x4*)(x + (size_t)(base + r) * DM) + X.lane + 64 * i);
#pragma unroll
        for (int r = 0; r < 4; ++r) { float a = 0.f;
#pragma unroll
            for (int i = 0; i < 4; ++i) a += v[r][i][0] * v[r][i][0] + v[r][i][1] * v[r][i][1] + v[r][i][2] * v[r][i][2] + v[r][i][3] * v[r][i][3];
            ss[r] = a; }
#pragma unroll
        for (int o = 32; o >= 1; o >>= 1)
#pragma unroll
            for (int r = 0; r < 4; ++r) ss[r] += __shfl_xor(ss[r], o);
#pragma unroll
        for (int r = 0; r < 4; ++r) {
            const float rinv = 1.0f / sqrtf(ss[r] * (1.0f / DM) + NORM_EPS);
#pragma unroll
            for (int i = 0; i < 4; ++i) {
                u32x2 w; w.x = cvt_pk_bf16(v[r][i][0] * rinv * gv[i][0], v[r][i][1] * rinv * gv[i][1]); w.y = cvt_pk_bf16(v[r][i][2] * rinv * gv[i][2], v[r][i][3] * rinv * gv[i][3]);
                *(u32x2*)(H + (size_t)(base + r) * DM + 4 * (X.lane + 64 * i)) = w;
            }
        }
    }
}

__device__ __forceinline__ void transpose_tile(const Ctx& X, const float* __restrict__ src, int ldsrc, int c0, int nvalid, int k0, bf16_t* __restrict__ dst, int ldd, int n0, int n0b = -1, const float* __restrict__ kscale = nullptr) {
    LAS float* tile = (LAS float*)X.lds;
    const int col = X.tid & 63, r0 = X.tid >> 6;
#pragma unroll
    for (int i = 0; i < 8; ++i) { const int row = r0 + 8 * i; float t_ = (col < nvalid) ? __builtin_nontemporal_load(src + (size_t)(k0 + row) * ldsrc + c0 + col) : 0.f; if (kscale) t_ *= kscale[k0 + row]; tile[row * 65 + col] = t_; }
    __syncthreads();
    const int nrow = X.tid >> 3, kseg = X.tid & 7;
    float v[8];
#pragma unroll
    for (int k = 0; k < 8; ++k) v[k] = tile[(kseg * 8 + k) * 65 + nrow];
    u32x4 w; w.x = cvt_pk_bf16(v[0], v[1]); w.y = cvt_pk_bf16(v[2], v[3]); w.z = cvt_pk_bf16(v[4], v[5]); w.w = cvt_pk_bf16(v[6], v[7]);
    const int drow = (n0b >= 0 && nrow >= 32) ? (n0b + nrow - 32) : (n0 + nrow);
    *(u32x4*)(dst + (size_t)drow * ldd + k0 + kseg * 8) = w;
    __syncthreads();
}

__device__ __forceinline__ void transpose_tile8(const Ctx& X, const float* __restrict__ src, int ldsrc, int c0, int k0, unsigned char* __restrict__ dst8, int ldd, int n0) {
    LAS float* tile = (LAS float*)X.lds;
    const int col = X.tid & 63, r0 = X.tid >> 6;
#pragma unroll
    for (int i = 0; i < 8; ++i) { const int row = r0 + 8 * i; tile[row * 65 + col] = __builtin_nontemporal_load(src + (size_t)(k0 + row) * ldsrc + c0 + col); }
    __syncthreads();
    const int nrow = X.tid >> 3, kseg = X.tid & 7;
    float v[8];
#pragma unroll
    for (int k = 0; k < 8; ++k) v[k] = tile[(kseg * 8 + k) * 65 + nrow] * W8_SCALE;
    u32x2 w; w.x = cvt4_fp8(v[0], v[1], v[2], v[3]); w.y = cvt4_fp8(v[4], v[5], v[6], v[7]);
    *(u32x2*)(dst8 + (size_t)(n0 + nrow) * ldd + k0 + kseg * 8) = w;
    __syncthreads();
}
__device__ __forceinline__ void win_group_src(int g, int& c0, int& nvalid) {
    nvalid = 64;
    if (g < 8) c0 = 64 * g;
    else if (g < 16) c0 = 640 + 64 * (g - 8);
    else if (g < 24) c0 = 1224 + 64 * (g - 16);
    else if (g < 32) c0 = 1736 + 64 * (g - 24);
    else if (g < 40) c0 = 2248 + 64 * (g - 32);
    else if (g == 40) c0 = 512;
    else if (g == 41) c0 = 576;
    else if (g == 42) c0 = 1152;
    else { c0 = 1216; nvalid = 8; }
}

__device__ __forceinline__ void p0_prologue(const Ctx& X, const Params& P) {
    unsigned char* ws = P.ws;
    {
        float* cst = (float*)(ws + WS_CONST);
        for (int i = X.wg * 512 + X.tid; i < C_END; i += X.nwg * 512) {
            float v;
            if (i < C_BDN) v = P.in[19][i];
            else if (i < C_GQA) v = P.in[21][i - C_BDN];
            else if (i < C_GKA) v = P.in[4][i - C_GQA];
            else if (i < C_GIK) v = P.in[5][i - C_GKA];
            else if (i < C_LQ1) v = P.in[6][i - C_GIK];
            else if (i < C_LK1) v = P.in[7][i - C_LQ1];
            else if (i < C_LQ2) v = P.in[8][i - C_LK1];
            else if (i < C_LK2) v = P.in[9][i - C_LQ2];
            else if (i < C_GQB) v = P.in[10][i - C_LK2];
            else if (i < C_GKB) v = P.in[11][i - C_GQB];
            else if (i < C_GSUB) v = P.in[12][i - C_GKB];
            else if (i < C_GFFN) v = P.in[13][i - C_GSUB];
            else if (i < C_BRT) v = P.in[15][i - C_GFFN];
            else v = P.in[17][i - C_BRT];
            cst[i] = v;
        }
    }
    p0_rmsnorm_rows(X, P.in[0], P.in[2], (bf16_t*)(ws + WS_H));
    {
        const int* pos = (const int*)P.in[1]; float* rope = (float*)(ws + WS_ROPE);
        for (int idx = X.wg * 512 + X.tid; idx < T_TOK * 8; idx += X.nwg * 512) {
            const int tok = idx >> 3, i = idx & 7;
            const float invf = i == 0 ? 1.0f : i == 1 ? 0.1939227432012558f : i == 2 ? 0.03760603070259094f : i == 3 ? 0.007292664609849453f : i == 4 ? 0.0014142135623842478f
                             : i == 5 ? 0.00027424818836152554f : i == 6 ? 5.3182957344688475e-05f : 1.0313385246263351e-05f;
            const float ang = (float)pos[tok] * invf;
            rope[tok * 16 + i] = cosf(ang); rope[tok * 16 + 8 + i] = sinf(ang);
        }
    }
    {
        const int ntile = 32 * 32 * 16;
        for (int t = X.wg; t < ntile; t += X.nwg) {
            const int kt = t & 15, q = (t >> 4) & 31, e = t >> 9;
            const int u = q >> 2, w = q & 3; const int c0 = (w < 2) ? (128 * u + 64 * w) : (1024 + 128 * u + 64 * (w - 2));
            transpose_tile8(X, P.in[18] + (size_t)e * 1024 * 2048, 2048, c0, kt * 64, ws + WS_WGU + (size_t)e * 2048 * 1024, 1024, q * 64);
        }
    }
    {
        const int ntile = 32 * 16 * 16;
        for (int t = X.wg; t < ntile; t += X.nwg) {
            const int kt = t & 15, q = (t >> 4) & 15, e = t >> 8;
            transpose_tile8(X, P.in[20] + (size_t)e * 1024 * 1024, 1024, q * 64, kt * 64, ws + WS_WD + (size_t)e * 1024 * 1024, 1024, q * 64);
        }
    }
    {
        const int ntile = NGROUP * 16;
        for (int t = X.wg; t < ntile; t += X.nwg) {
            const int kt = t & 15, g = t >> 4; int c0, nv; win_group_src(g, c0, nv);
            transpose_tile(X, P.in[3], 2760, c0, nv, kt * 64, (bf16_t*)(ws + WS_WIN), 1024, 256 * (g >> 2) + 32 * (g & 3), 256 * (g >> 2) + 128 + 32 * (g & 3));
        }
    }
    {
        for (int t = X.wg; t < 256; t += X.nwg) { const int kt = t & 15, q = t >> 4; transpose_tile(X, P.in[14], 1024, q * 64, 64, kt * 64, (bf16_t*)(ws + WS_WO), 1024, q * 64); }
    }
    {
        for (int t = X.wg; t < 16; t += X.nwg) transpose_tile(X, P.in[16], 32, 0, 32, t * 64, (bf16_t*)(ws + WS_WR), 1024, 0, -1, P.in[15]);
    }
}

typedef short v4i16_t __attribute__((ext_vector_type(4)));
__device__ __forceinline__ s16x4 tr16(const LAS unsigned char* p) { return __builtin_bit_cast(s16x4, __builtin_amdgcn_ds_read_tr16_b64_v4i16((LAS v4i16_t*)p)); }
__device__ __forceinline__ void dma16(const void* g, LAS unsigned char* l) {
    const unsigned base = (unsigned)__builtin_amdgcn_readfirstlane((int)(unsigned)(uintptr_t)l); unsigned sv;
    asm volatile("s_mov_b32 %0, m0\n\ts_mov_b32 m0, %2\n\ts_nop 0\n\tglobal_load_lds_dwordx4 %1, off\n\ts_mov_b32 m0, %0" : "=&s"(sv) : "v"(g), "s"(base) : "memory"); }
__device__ __forceinline__ bf16x8 ldsfrag(const LAS unsigned char* p) { return *(const LAS bf16x8*)p; }
constexpr int L2_FB = 1024, L2_CB = 5120, L2_ZM = 9216  , L2_WL = 17408, L2_ZT = 18432, L2_QI = 20480, L2_M8 = 20480  ,
              L2_XB = 20480  , L2_KIW = 53248  , L2_KVB = 86016  , L2_DIFF = 20480;


__device__ __forceinline__ void count_ge4(int& c0, int& c1, float x0, float x1, float x2, float x3, float t) {
    unsigned long long m0, m1, m2, m3;
    asm volatile("v_cmp_ge_f32_e64 %2, %6, %10\n\tv_cmp_ge_f32_e64 %3, %7, %10\n\tv_cmp_ge_f32_e64 %4, %8, %10\n\tv_cmp_ge_f32_e64 %5, %9, %10\n\t"
                 "v_addc_co_u32_e64 %0, vcc, 0, %0, %2\n\tv_addc_co_u32_e64 %1, vcc, 0, %1, %3\n\tv_addc_co_u32_e64 %0, vcc, 0, %0, %4\n\tv_addc_co_u32_e64 %1, vcc, 0, %1, %5"
                 : "+v"(c0), "+v"(c1), "=&s"(m0), "=&s"(m1), "=&s"(m2), "=&s"(m3) : "v"(x0), "v"(x1), "v"(x2), "v"(x3), "v"(t) : "vcc");
}

__device__ __forceinline__ void dsa_unit(const Ctx& X, const Params& P, LAS unsigned char* ldsall, int b, int qt) {
    unsigned char* ws = P.ws;
    const bf16_t* QI = (const bf16_t*)(ws + WS_QI); const bf16_t* KI = (const bf16_t*)(ws + WS_KI); const float* WI = (const float*)(ws + WS_WI);
    const bf16_t* QA = (const bf16_t*)(ws + WS_QA); const bf16_t* KA = (const bf16_t*)(ws + WS_KA); const bf16_t* VA = (const bf16_t*)(ws + WS_VAT);
    bf16_t* Y = (bf16_t*)(ws + WS_H);
    const int wid = X.wid, lane = lane_id(), c = lane & 31, h = lane >> 5;
    const int q0 = qt * 32, chunk = q0 >> 6, nkb = 2 * (chunk + 1);
    const int tokq = b * SEQ + q0 + c;
    LAS float* fb = (LAS float*)(ldsall + L2_FB);
    LAS int* cb = (LAS int*)(ldsall + L2_CB);
    LAS unsigned char* m8 = ldsall + L2_M8;
    LAS unsigned char* qis = ldsall + L2_QI;
    LAS unsigned char* kv = ldsall + L2_KVB;
#define KVSLOT(tt) (kv + (((tt) + 2) % 3) * 16384)
    __syncthreads();
    const bf16_t* ksrc = KA + (size_t)b * 131072 + wid * 512 + lane * 8;
    const bf16_t* vsrc = VA + (size_t)(b * SEQ + 16 * (wid & 3) + (lane >> 2)) * 64 + (wid >> 2) * 32 + (lane & 3) * 8;
    dma16(ksrc, KVSLOT(0) + wid * 1024); dma16(vsrc, KVSLOT(0) + 8192 + wid * 1024);
    if (nkb <= 8) {
        *(LAS u32x4*)(m8 + (wid * 64 + lane) * 16) = (u32x4){0u, 0u, 0u, 0u};
    } else {
        LAS float* wl = (LAS float*)(ldsall + L2_WL);
        if (wid == 0 && h == 0) { *(LAS f32x4*)(wl + c * 8) = *(const f32x4*)(WI + (size_t)tokq * 8); *(LAS f32x4*)(wl + c * 8 + 4) = *(const f32x4*)(WI + (size_t)tokq * 8 + 4); }
#pragma unroll
        for (int i = 0; i < 4; ++i) { const int piece = wid * 4 + i, head = piece >> 2, cp = piece & 3;
            dma16(QI + (size_t)(b * SEQ + q0 + (lane & 31)) * 512 + head * 64 + (2 * cp + (lane >> 5)) * 8, qis + piece * 1024); }
        asm volatile("s_waitcnt vmcnt(0)" ::: "memory");
        __syncthreads();
        f32x16 sc[8];
        LAS unsigned char* kiw = ldsall + L2_KIW + wid * 8192;
        const bf16_t* kisrc = KI + (size_t)b * 131072 + lane * 8;
#define KI_DMA(kb_, buf_) do { _Pragma("unroll") for (int j_ = 0; j_ < 4; ++j_) dma16(kisrc + (size_t)(kb_) * 2048 + 512 * j_, kiw + (buf_) * 4096 + j_ * 1024); } while (0)
        KI_DMA(wid, 0);
#pragma unroll
        for (int i = 0; i < 8; ++i) {
            const int kb = wid + 8 * i;
            f32x16 a = zero16();
            if (kb < nkb) {
                if (i < 7 && kb + 8 < nkb) { KI_DMA(kb + 8, (i + 1) & 1); asm volatile("s_waitcnt vmcnt(4)" ::: "memory"); }
                else asm volatile("s_waitcnt vmcnt(0)" ::: "memory");
                const LAS unsigned char* kbuf = kiw + (i & 1) * 4096;
                bf16x8 kf[4];
#pragma unroll
                for (int s = 0; s < 4; ++s) kf[s] = ldsfrag(kbuf + (2 * s + h) * 512 + c * 16);
#define IDX_Q(hd_, s_) ldsfrag(qis + (hd_) * 4096 + (2 * (s_) + h) * 512 + c * 16)
#define IDX_VALU4(Sx, w_, s_) do { _Pragma("unroll") for (int e_ = 0; e_ < 4; ++e_) { const float rl_ = __builtin_amdgcn_fmed3f(Sx[4 * (s_) + e_], 0.0f, 3.0e38f);     \
                    asm("v_fmac_f32 %0, %1, %2" : "+v"(a[4 * (s_) + e_]) : "v"(w_), "v"(rl_)); } } while (0)
                f32x16 SA = zero16();
#pragma unroll
                for (int s = 0; s < 4; ++s) SA = MFMA32(kf[s], IDX_Q(0, s), SA);
#pragma unroll 1
                for (int hp = 0; hp < 3; ++hp) {
                    const float w0 = wl[c * 8 + 2 * hp], w1 = wl[c * 8 + 2 * hp + 1];
                    f32x16 SB = zero16();
#pragma unroll
                    for (int s = 0; s < 4; ++s) { SB = MFMA32(kf[s], IDX_Q(2 * hp + 1, s), SB); IDX_VALU4(SA, w0, s); }
                    f32x16 SC = zero16();
#pragma unroll
                    for (int s = 0; s < 4; ++s) { SC = MFMA32(kf[s], IDX_Q(2 * hp + 2, s), SC); IDX_VALU4(SB, w1, s); }
                    SA = SC;
                }
                {
                    const float w6 = wl[c * 8 + 6], w7 = wl[c * 8 + 7];
                    f32x16 SB = zero16();
#pragma unroll
                    for (int s = 0; s < 4; ++s) { SB = MFMA32(kf[s], IDX_Q(7, s), SB); IDX_VALU4(SA, w6, s); }
#pragma unroll
                    for (int s = 0; s < 4; ++s) IDX_VALU4(SB, w7, s);
                }
#undef IDX_Q
#undef IDX_VALU4
            } else {
#pragma unroll
                for (int r = 0; r < 16; ++r) a[r] = -INFINITY;
            }
            sc[i] = a;
        }
#undef KI_DMA
        const int cq = 4 * wid + (lane >> 4), pl = lane & 15;
        {
            LAS unsigned char* xw = ldsall + L2_XB + (2 * wid + h) * 2064 + c * 64; const int swz_w = (c >> 2) & 3;
            LAS unsigned char* xr = ldsall + L2_XB + pl * 2064 + cq * 64; const int swz_r = (cq >> 2) & 3;
            __syncthreads();
#pragma unroll
            for (int i = 0; i < 8; ++i) if (8 * i < nkb) {
#pragma unroll
                for (int q4 = 0; q4 < 4; ++q4) *(LAS f32x4*)(xw + (i & 1) * 33024 + 16 * (q4 ^ swz_w)) = (f32x4){sc[i][4 * q4], sc[i][4 * q4 + 1], sc[i][4 * q4 + 2], sc[i][4 * q4 + 3]};
                __syncthreads();
#pragma unroll
                for (int q4 = 0; q4 < 4; ++q4) { const f32x4 v = *(const LAS f32x4*)(xr + (i & 1) * 33024 + 16 * (q4 ^ swz_r)); sc[i][4 * q4] = v[0]; sc[i][4 * q4 + 1] = v[1]; sc[i][4 * q4 + 2] = v[2]; sc[i][4 * q4 + 3] = v[3]; }
            }
            __syncthreads();
        }
#define DPP_I(x, ctrl) __builtin_amdgcn_update_dpp(0, (x), (ctrl), 0xF, 0xF, true)
#define DPP_F(x, ctrl) __int_as_float(DPP_I(__float_as_int(x), (ctrl)))
        float mn = INFINITY, mx = -INFINITY;
#pragma unroll
        for (int i = 0; i < 8; ++i) if (8 * i < nkb) {
            const bool val = (pl >> 1) + 8 * i < nkb;
#pragma unroll
            for (int r = 0; r < 16; ++r) { mn = fminf(mn, val ? sc[i][r] : INFINITY); mx = fmaxf(mx, sc[i][r]); }
        }
        mn = fminf(mn, DPP_F(mn, 0xB1)); mn = fminf(mn, DPP_F(mn, 0x4E)); mn = fminf(mn, DPP_F(mn, 0x141)); mn = fminf(mn, DPP_F(mn, 0x140));
        mx = fmaxf(mx, DPP_F(mx, 0xB1)); mx = fmaxf(mx, DPP_F(mx, 0x4E)); mx = fmaxf(mx, DPP_F(mx, 0x141)); mx = fmaxf(mx, DPP_F(mx, 0x140));
        float lo = mn, hi = mx;
        bool done = false; float thr = lo; int tot0 = 0;
        LAS int* ztl = (LAS int*)(ldsall + L2_ZT) + wid * 64 + lane;
        int nval = 0;
#pragma unroll
        for (int i = 0; i < 8; ++i) nval += (8 * i < nkb) ? 16 : 0;
        for (int it = 0; it < 66; ++it) {
            const float mid = 0.5f * lo + 0.5f * hi;
            const bool degenerate = !(mid > lo && mid < hi);
            const float t = done ? thr : (it == 0 ? 1e-30f : (it == 1 ? 0.0f : mid));
            unsigned a0 = 0u, a1 = 0u, a2 = 0u, a3 = 0u; const f32x2_t tt = (f32x2_t){t, t};
#pragma unroll
            for (int i = 0; i < 8; ++i) if (8 * i < nkb) {
#pragma unroll
                for (int r = 0; r < 16; r += 4) {
                    const f32x2_t d01 = (f32x2_t){sc[i][r], sc[i][r + 1]} - tt, d23 = (f32x2_t){sc[i][r + 2], sc[i][r + 3]} - tt;
                    a0 = __builtin_amdgcn_alignbit(a0, __float_as_uint(d01.x), 31); a1 = __builtin_amdgcn_alignbit(a1, __float_as_uint(d01.y), 31);
                    a2 = __builtin_amdgcn_alignbit(a2, __float_as_uint(d23.x), 31); a3 = __builtin_amdgcn_alignbit(a3, __float_as_uint(d23.y), 31);
                }
            }
            int tot = nval - (__builtin_popcount(a0) + __builtin_popcount(a1) + __builtin_popcount(a2) + __builtin_popcount(a3));
            tot += DPP_I(tot, 0xB1); tot += DPP_I(tot, 0x4E); tot += DPP_I(tot, 0x141); tot += DPP_I(tot, 0x140);
#define ZERO_PROBES(c0, c1) do { *ztl = ((c0) > 256 && (c1) < 256) ? 256 - (c1) : -1; \
                if ((c0) >= 256 && (c1) < 256) { done = true; thr = 0.0f; } \
                else if ((c1) >= 256) { lo = fmaxf(lo, 1e-30f); if ((c1) == 256) { done = true; thr = 1e-30f; } } \
                else hi = fminf(hi, 0.0f); } while (0)
            if (it == 0) { tot0 = tot;
                if (!__any(tot < 256)) { ZERO_PROBES(tot, tot); it = 1; } }
            else if (it == 1) ZERO_PROBES(tot, tot0);
            else if (!done) {
                if (degenerate) { done = true; thr = lo; }
                else if (tot == 256) { done = true; thr = mid; }
                else if (tot > 256) lo = mid; else hi = mid;
            }
#undef ZERO_PROBES
            if (__all(done)) break;
        }
#undef DPP_I
#undef DPP_F
        if (!done) thr = lo;
        const int ztake = *ztl; const bool tie = ztake >= 0;
        const int hn = pl & 1;
#pragma unroll
        for (int i = 0; i < 8; ++i) if (8 * i < nkb) {
            u32x4 w = (u32x4){0u, 0u, 0u, 0u};
#pragma unroll
            for (int r = 0; r < 16; ++r) w[r >> 2] |= (sc[i][r] >= thr) ? 0u : (0xFEu << (8 * (r & 3)));
            *(LAS u32x4*)(m8 + ((pl + 16 * i) * 32 + cq) * 16) = w;
        }
        if (__any(tie)) {
            LAS unsigned short* zmask16 = (LAS unsigned short*)(ldsall + L2_ZM);
#pragma unroll
            for (int i = 0; i < 8; ++i) if (8 * i < nkb) {
                unsigned z = 0;
#pragma unroll
                for (int r = 0; r < 16; ++r) z |= (sc[i][r] == 0.0f) ? (1u << r) : 0u;
                zmask16[cq * 128 + pl + 16 * i] = (unsigned short)z;
            }
            asm volatile("s_waitcnt lgkmcnt(0)" ::: "memory");
            const LAS unsigned* zw = (const LAS unsigned*)(ldsall + L2_ZM);
            int prefix = 0, kdone = 0;
#pragma unroll 1
            for (int kb = pl >> 1; kb < nkb; kb += 8) {
#pragma unroll 1
                for (; kdone < kb; ++kdone) prefix += __builtin_popcount(zw[cq * 64 + kdone]);
                const unsigned w = zw[cq * 64 + kb], b0 = w & 0xffffu, b1 = w >> 16;
                unsigned W = 0;
#pragma unroll
                for (int g = 0; g < 4; ++g) W |= (((b0 >> (4 * g)) & 0xfu) << (8 * g)) | (((b1 >> (4 * g)) & 0xfu) << (8 * g + 4));
                const unsigned mine = hn ? b1 : b0; unsigned add = 0;
#pragma unroll
                for (int r = 0; r < 16; ++r) { const int rho = crow(r, hn); const int rank = prefix + __builtin_popcount(W & ((1u << rho) - 1u)); add |= (((mine >> r) & 1u) && rank >= ztake) ? (1u << r) : 0u; }
                if (tie) { LAS u32x4* mp_ = (LAS u32x4*)(m8 + ((kb * 2 + hn) * 32 + cq) * 16); u32x4 w2 = *mp_;
#pragma unroll
                    for (int r = 0; r < 16; ++r) w2[r >> 2] |= (0u - ((add >> r) & 1u)) & (0xFEu << (8 * (r & 3)));
                    *mp_ = w2; }
            }
        }
    }
    {
        const bf16_t* qp = QA + (size_t)tokq * 512 + wid * 64 + 8 * h;
        bf16x8 qr[4];
#pragma unroll
        for (int s = 0; s < 4; ++s) qr[s] = ldfrag(qp + 16 * s);
        asm volatile("" : "+v"(qr[0]), "+v"(qr[1]), "+v"(qr[2]), "+v"(qr[3]));
        f32x16 O[2]; O[0] = zero16(); O[1] = zero16(); float l = 0.f;
        const int vbase = ((lane >> 4) & 1) * 32 + (lane & 3) * 8 + (4 * h + ((lane & 15) >> 2)) * 64;
        const int lane2 = lane_id();
        const bf16_t* ksrc2 = KA + (size_t)b * 131072 + wid * 512 + lane2 * 8;
        const bf16_t* vsrc2 = VA + (size_t)(b * SEQ + 16 * (wid & 3) + (lane2 >> 2)) * 64 + (wid >> 2) * 32 + (lane2 & 3) * 8;
#define DSA_DMA(tt) do { LAS unsigned char* ns_ = KVSLOT(tt); dma16(ksrc2 + (size_t)(tt) * 4096, ns_ + wid * 1024); dma16(vsrc2 + (size_t)(tt) * 64 * 64, ns_ + 8192 + wid * 1024); } while (0)
        if (chunk >= 1) DSA_DMA(1);
        for (int t = 0; t <= chunk; ++t) {
            if (t + 1 <= chunk) asm volatile("s_waitcnt vmcnt(2)" ::: "memory"); else asm volatile("s_waitcnt vmcnt(0)" ::: "memory");
            __syncthreads();
            if (t + 2 <= chunk) DSA_DMA(t + 2);
            const LAS unsigned char* ks = KVSLOT(t) + (h * 1024 + c * 16); const LAS unsigned char* vs = KVSLOT(t) + 8192 + vbase;
            asm volatile("" : "+v"(ks), "+v"(vs));
            f32x16 S[2];
#pragma unroll
            for (int blk = 0; blk < 2; ++blk) {
                const u32x4 mw = *(const LAS u32x4*)(m8 + (((2 * t + blk) * 2 + h) * 32 + c) * 16);
                f32x16 a;
#pragma unroll
                for (int r = 0; r < 16; ++r) a[r] = __uint_as_float(mw[r >> 2] << (24 - 8 * (r & 3)));
#pragma unroll
                for (int s = 0; s < 4; ++s) a = MFMA32(ldsfrag(ks + 2048 * s + 512 * blk), qr[s], a);
#pragma unroll
                for (int r = 0; r < 16; ++r) { const float p = __builtin_amdgcn_exp2f(a[r]); l += p; a[r] = p; }
                S[blk] = a;
            }
#pragma unroll
            for (int s4 = 0; s4 < 4; ++s4) {
                const bf16x8 pf = pack8(S[s4 >> 1], 8 * (s4 & 1));
#pragma unroll
                for (int db = 0; db < 2; ++db) {
                    const s16x4 v0 = tr16(vs + db * 4096 + s4 * 1024), v1 = tr16(vs + db * 4096 + s4 * 1024 + 512);
                    const bf16x8 vf = (bf16x8){v0[0], v0[1], v0[2], v0[3], v1[0], v1[1], v1[2], v1[3]};
                    O[db] = MFMA32(vf, pf, O[db]);
                }
            }
        }
#undef DSA_DMA
#undef KVSLOT
        l += __shfl_xor(l, 32);
        const float inv = 1.0f / l;
        int hh = h; asm volatile("" : "+v"(hh));
        bf16_t* yrow = Y + (size_t)tokq * DM + wid * 64;
        u32x2 w[8];
#pragma unroll
        for (int db = 0; db < 2; ++db)
#pragma unroll
            for (int rg = 0; rg < 4; ++rg) { w[4 * db + rg].x = cvt_pk_bf16(O[db][4 * rg] * inv, O[db][4 * rg + 1] * inv); w[4 * db + rg].y = cvt_pk_bf16(O[db][4 * rg + 2] * inv, O[db][4 * rg + 3] * inv); }
        unsigned char* yb = (unsigned char*)yrow + 16 * hh;
#pragma unroll
        for (int k = 0; k < 8; k += 2) {
            const auto rx = __builtin_amdgcn_permlane32_swap(w[k].x, w[k + 1].x, false, false), ry = __builtin_amdgcn_permlane32_swap(w[k].y, w[k + 1].y, false, false);
            *(u32x4*)(yb + 16 * k) = (u32x4){(unsigned)rx[0], (unsigned)ry[0], (unsigned)rx[1], (unsigned)ry[1]};
        }
    }
}

__device__ __forceinline__ void diff_unit(const Ctx& X, const Params& P, LAS unsigned char* ldsall, int b, int hb, int qt16, float lam) {
    unsigned char* ws = P.ws;
    const bf16_t* QB = (const bf16_t*)(ws + WS_QB); const bf16_t* KB = (const bf16_t*)(ws + WS_KB); const bf16_t* VB = (const bf16_t*)(ws + WS_VBT);
    bf16_t* Y = (bf16_t*)(ws + WS_H);
    const float* gsub = CF(ws, C_GSUB);
    const int wid = X.wid, lane = lane_id(), c = lane & 31, h = lane >> 5, qg = wid & 3, mp = wid >> 2;
    const int q0 = qt16 * 128 + 32 * qg, chunk = q0 >> 6, ntile = 2 * qt16 + 2;
    const int tokq = b * SEQ + q0 + c;
    LAS unsigned char* ring = ldsall + L2_DIFF;
    bf16x8 qf[4];
    { const bf16_t* qp = QB + (size_t)tokq * 512 + hb * 128 + mp * 64 + 8 * h;
#pragma unroll
      for (int s = 0; s < 4; ++s) qf[s] = ldfrag(qp + 16 * s); }
    asm volatile("" : "+v"(qf[0]), "+v"(qf[1]), "+v"(qf[2]), "+v"(qf[3]));
    const bf16_t* k1src = KB + (size_t)((b * 4 + hb) * 2) * 131072 + wid * 512 + lane * 8;
    const bf16_t* vsrc0 = VB + (size_t)(b * SEQ + 16 * (wid & 3) + (lane >> 2)) * 512 + hb * 128 + (wid >> 2) * 32 + (lane & 3) * 8;
    __syncthreads();
#define DIFF_DMA(tt) do { LAS unsigned char* ns_ = ring + ((tt) % 3) * 32768; const bf16_t* kn_ = k1src + (size_t)(tt) * 4096; const bf16_t* vn_ = vsrc0 + (size_t)(tt) * 64 * 512; \
        dma16(kn_, ns_ + wid * 1024); dma16(kn_ + 131072, ns_ + 8192 + wid * 1024); dma16(vn_, ns_ + 16384 + wid * 1024); dma16(vn_ + 64, ns_ + 16384 + (wid + 8) * 1024); } while (0)
    DIFF_DMA(0); if (ntile > 1) DIFF_DMA(1);
    f32x16 O[4];
#pragma unroll
    for (int db = 0; db < 4; ++db) O[db] = zero16();
    float l = 0.f;
    const int vbase = ((lane >> 4) & 1) * 32 + (lane & 3) * 8 + (4 * h + ((lane & 15) >> 2)) * 64;
    for (int t = 0; t < ntile; ++t) {
        if (t + 1 < ntile) asm volatile("s_waitcnt vmcnt(4)" ::: "memory"); else asm volatile("s_waitcnt vmcnt(0)" ::: "memory");
        __syncthreads();
        if (t + 2 < ntile) DIFF_DMA(t + 2);
        if (t <= chunk) {
            const LAS unsigned char* ks = ring + (t % 3) * 32768 + mp * 8192 + (h * 1024 + c * 16); const LAS unsigned char* vs = ring + (t % 3) * 32768 + 16384 + vbase;
            asm volatile("" : "+v"(ks), "+v"(vs));
            f32x16 A[2];
#pragma unroll
            for (int blk = 0; blk < 2; ++blk) {
                f32x16 s1 = zero16();
#pragma unroll
                for (int s = 0; s < 4; ++s) s1 = MFMA32(ldsfrag(ks + 2048 * s + 512 * blk), qf[s], s1);
#pragma unroll
                for (int r = 0; r < 16; ++r) { s1[r] = __builtin_amdgcn_exp2f(s1[r]); l += s1[r]; }
                A[blk] = s1;
            }
#pragma unroll
            for (int s4 = 0; s4 < 4; ++s4) {
                const bf16x8 pf = pack8(A[s4 >> 1], 8 * (s4 & 1));
#pragma unroll
                for (int db = 0; db < 4; ++db) {
                    const s16x4 v0 = tr16(vs + db * 4096 + s4 * 1024), v1 = tr16(vs + db * 4096 + s4 * 1024 + 512);
                    const bf16x8 vf = (bf16x8){v0[0], v0[1], v0[2], v0[3], v1[0], v1[1], v1[2], v1[3]};
                    O[db] = MFMA32(vf, pf, O[db]);
                }
            }
        }
    }
#undef DIFF_DMA
    l += __shfl_xor(l, 32);
    __syncthreads();
    LAS float* comb = (LAS float*)ring + qg * 4096;
    if (mp == 1) {
        const float sc = lam / l;
#pragma unroll
        for (int db = 0; db < 4; ++db)
#pragma unroll
            for (int r = 0; r < 16; ++r) comb[(db * 16 + r) * 64 + lane] = O[db][r] * sc;
    }
    __syncthreads();
    if (mp == 0) {
        const float inv = 1.0f / l;
        float ss = 0.f;
#pragma unroll
        for (int db = 0; db < 4; ++db)
#pragma unroll
            for (int r = 0; r < 16; ++r) { const float o = O[db][r] * inv - comb[(db * 16 + r) * 64 + lane]; O[db][r] = o; ss += o * o; }
        ss += __shfl_xor(ss, 32);
        const float rinv = (1.0f - LAM_INIT) / sqrtf(ss * (1.0f / 128.0f) + NORM_EPS);
        int hh = h; asm volatile("" : "+v"(hh));
        bf16_t* yrow = Y + (size_t)tokq * DM + 512 + hb * 128;
        unsigned char* yb = (unsigned char*)yrow + 16 * hh;
#pragma unroll
        for (int db = 0; db < 4; ++db)
#pragma unroll
            for (int rp = 0; rp < 4; rp += 2) {
                u32x2 w[2];
#pragma unroll
                for (int q = 0; q < 2; ++q) { const int rg = rp + q, d = 32 * db + 8 * rg + 4 * hh;
                    const f32x4 gv = *(const f32x4*)(gsub + d);
                    w[q].x = cvt_pk_bf16(O[db][4 * rg] * rinv * gv[0], O[db][4 * rg + 1] * rinv * gv[1]); w[q].y = cvt_pk_bf16(O[db][4 * rg + 2] * rinv * gv[2], O[db][4 * rg + 3] * rinv * gv[3]); }
                const auto rx = __builtin_amdgcn_permlane32_swap(w[0].x, w[1].x, false, false), ry = __builtin_amdgcn_permlane32_swap(w[0].y, w[1].y, false, false);
                *(u32x4*)(yb + 16 * (4 * db + rp)) = (u32x4){(unsigned)rx[0], (unsigned)ry[0], (unsigned)rx[1], (unsigned)ry[1]};
            }
    }
}

__device__ __forceinline__ void p2_mixers(const Ctx& X, const Params& P, LAS unsigned char* ldsall) {
    const bool xl = (X.nwg & 7) == 0; const int gx = X.nwg >> 3;
    for (int i = 0;; ++i) {
        int u; if (xl) { const int v = X.mk + gx * i; if (v >= 128) break; u = X.mx * 128 + v; } else { u = X.wg + X.nwg * i; if (u >= NBATCH * 32) break; }
        const int b = u >> 5, j = ((u & 31) + (((X.nwg & 31) == 0) ? 8 * i : 0)) & 31;
        dsa_unit(X, P, ldsall, b, j);
        dsa_unit(X, P, ldsall, b, 63 - j);
    }
    float lam;
    { const float a = wave_sum(CF(P.ws, C_LQ1)[X.lane] * CF(P.ws, C_LK1)[X.lane]), bq = wave_sum(CF(P.ws, C_LQ2)[X.lane] * CF(P.ws, C_LK2)[X.lane]); lam = expf(a) - expf(bq) + LAM_INIT; }
    for (int i = 0;; ++i) {
        int u; if (xl) { const int v = X.mk + gx * i; if (v >= 128) break; u = X.mx * 128 + v; } else { u = X.wg + X.nwg * i; if (u >= NBATCH * 4 * 8) break; }
        const int j = u & 7, hb = (u >> 3) & 3, b = u >> 5;
        diff_unit(X, P, ldsall, b, hb, j, lam);
        diff_unit(X, P, ldsall, b, hb, 15 - j, lam);
    }
}

namespace g8 {
typedef float f32x4 __attribute__((ext_vector_type(4)));
constexpr int BM = 256, BK = 64, HALF = 128, HTB = HALF * BK * 2, STAGE_BYTES = 8 * HTB, KDIM = 1024, NT = KDIM / BK;
__device__ __forceinline__ int lds_byte(int r, int c) { const int st = (r >> 4) * 2 + (c >> 5), rr = r & 15, cc = c & 31, ob = rr * 64 + cc * 2; return st * 1024 + (ob ^ (((ob >> 9) & 1) << 5)); }
__device__ __forceinline__ void stage_rc(int b, int& R, int& C) { const int st = b / 1024, sb = b % 1024, swz = sb ^ (((sb >> 9) & 1) << 5); R = (st >> 1) * 16 + swz / 64; C = (st & 1) * 32 + (swz % 64) / 2; }
__device__ __forceinline__ int perm32(int rho) { const int n = rho >> 4, i = rho & 15; return 8 * (i >> 2) + 4 * n + (i & 3); }

struct Unit { int rt, pn, e, row0, nvalid; };

template <class Epi, class Sched, bool GATHER, bool F8 = false>
__device__ __forceinline__ void gemm_phase(LAS unsigned char* lds, LAS unsigned char* ldsidx, const Sched& S, const Epi& E, int wid_) {
    int lane = lane_id(); asm volatile("" : "+v"(lane));
    const int wid = wid_, tid = wid * 64 + lane, wr = wid >> 2, wc = wid & 3, fr = lane & 15, fq = lane >> 4;
    constexpr int RP = F8 ? 1024 : 2048, nt = RP / 128;
    unsigned voffB[2], cu[2][2];
#pragma unroll
    for (int i = 0; i < 2; ++i) { int R, C; stage_rc(tid * 16 + i * 8192, R, C); const int Rb = Epi::PERM ? ((R & ~31) + perm32(R & 31)) : R;
        voffB[i] = (unsigned)(Rb * RP + C * 2);
        cu[0][i] = (unsigned)(R * RP + C * 2); cu[1][i] = (unsigned)((R + HALF) * RP + C * 2); }
    const size_t kstep = (size_t)(BK * 2);
    const size_t hstep = (size_t)HALF * RP;
    const unsigned lbase = (unsigned)__builtin_amdgcn_readfirstlane((int)((unsigned)(uintptr_t)lds + (unsigned)wid * 1024u));
    const int aoff = F8 ? lds_byte(wr * 64 + fr, fq * 16) : lds_byte(wr * 64 + fr, fq * 8), boff = F8 ? lds_byte(wc * 32 + fr, fq * 16) : lds_byte(wc * 32 + fr, fq * 8);
    constexpr int KOFF = F8 ? 16 : 1024;
#define G8_SA(b, h) (((b) * 2 + (h)) * HTB)
#define G8_SB(b, h) ((4 + (b) * 2 + (h)) * HTB)
#define G8_DMA(gbase, voff, ldsoff) do { unsigned sv_; \
        asm volatile("s_mov_b32 %0, m0\n\ts_add_u32 m0, %3, %4\n\ts_nop 0\n\tglobal_load_lds_dwordx4 %1, %2\n\ts_mov_b32 m0, %0" : "=&s"(sv_) : "v"(voff), "s"(gbase), "s"(lbase), "n"(ldsoff) : "memory", "scc"); } while (0)
#define G8_STAGEB(bufoff, gbase) do { G8_DMA((gbase), voffB[0], (bufoff)); G8_DMA((gbase), voffB[1], (bufoff) + 8192); } while (0)
#define G8_STAGEA_(bufoff, gbase, o0, o1) do { G8_DMA((gbase), (o0), (bufoff)); G8_DMA((gbase), (o1), (bufoff) + 8192); } while (0)
#define G8_STAGEA(bufoff, gbase, hh) do { if constexpr (GATHER) { G8_STAGEA_(bufoff, gbase, cu[hh][0], cu[hh][1]); } else { G8_STAGEA_(bufoff, (gbase) + (hh) * hstep, cu[0][0], cu[0][1]); } } while (0)
#define G8_LDA(dst, b, h) do { _Pragma("unroll") for (int m = 0; m < 4; ++m) _Pragma("unroll") for (int k = 0; k < 2; ++k) dst[m][k] = *(const LAS bf16x8*)(lds + G8_SA(b, h) + aoff + m * 2048 + k * KOFF); } while (0)
#define G8_LDB(dst, b, h) do { _Pragma("unroll") for (int n = 0; n < 2; ++n) _Pragma("unroll") for (int k = 0; k < 2; ++k) dst[n][k] = *(const LAS bf16x8*)(lds + G8_SB(b, h) + boff + n * 2048 + k * KOFF); } while (0)
#define G8_MMA(ai, bj, At, Bt) do { __builtin_amdgcn_s_setprio(1); \
        if constexpr (F8) { _Pragma("unroll") for (int m = 0; m < 4; ++m) _Pragma("unroll") for (int n = 0; n < 2; ++n) { \
            const u32x4 b0_ = __builtin_bit_cast(u32x4, Bt[n][0]), b1_ = __builtin_bit_cast(u32x4, Bt[n][1]), a0_ = __builtin_bit_cast(u32x4, At[m][0]), a1_ = __builtin_bit_cast(u32x4, At[m][1]); \
            const v8i32 bw_ = (v8i32){(int)b0_.x, (int)b0_.y, (int)b0_.z, (int)b0_.w, (int)b1_.x, (int)b1_.y, (int)b1_.z, (int)b1_.w}, aw_ = (v8i32){(int)a0_.x, (int)a0_.y, (int)a0_.z, (int)a0_.w, (int)a1_.x, (int)a1_.y, (int)a1_.z, (int)a1_.w}; \
            acc[ai][bj][m][n] = __builtin_amdgcn_mfma_scale_f32_16x16x128_f8f6f4(bw_, aw_, acc[ai][bj][m][n], 0, 0, 0, W8_E8M0, 0, ONE_E8M0); } } \
        else { _Pragma("unroll") for (int m = 0; m < 4; ++m) _Pragma("unroll") for (int n = 0; n < 2; ++n) _Pragma("unroll") for (int k = 0; k < 2; ++k) \
            acc[ai][bj][m][n] = __builtin_amdgcn_mfma_f32_16x16x32_bf16(Bt[n][k], At[m][k], acc[ai][bj][m][n], 0, 0, 0); } \
        __builtin_amdgcn_s_setprio(0); } while (0)
#define G8_WAIT_V(n) asm volatile("s_waitcnt vmcnt(" #n ")" ::: "memory")
#define G8_WAIT_L(n) asm volatile("s_waitcnt lgkmcnt(" #n ")" ::: "memory")
#define G8_BAR __builtin_amdgcn_s_barrier()
#define G8_SCHED __builtin_amdgcn_sched_barrier(0)
    Unit cur, nxt; int ui = 0;
    if (!S.next(0, cur)) return;
    f32x4 acc[2][2][4][2];
    {
        f32x4 nb0[2][2];
        if constexpr (Epi::BIAS) { int t3_ = lane_id(); asm volatile("" : "+v"(t3_)); E.bias(cur, wc, t3_ >> 4, nb0); }
#pragma unroll
        for (int a = 0; a < 2; ++a)
#pragma unroll
            for (int b = 0; b < 2; ++b)
#pragma unroll
                for (int m = 0; m < 4; ++m)
#pragma unroll
                    for (int n = 0; n < 2; ++n) { if constexpr (Epi::BIAS) acc[a][b][m][n] = nb0[b][n]; else acc[a][b][m][n] = (f32x4){0.f, 0.f, 0.f, 0.f}; }
    }
    bf16x8 At[4][2], B0[2][2], B1[2][2];
    const char* cA = S.a_ptr(cur); const char* cB = S.b_ptr(cur);
    if constexpr (GATHER) {
        if (wid < 4) __builtin_amdgcn_global_load_lds((const unsigned*)(S.idx_ptr(cur) + wid * 64 + lane), (LAS unsigned*)(ldsidx + wid * 256), 4, 0, 0);
        G8_WAIT_V(0); G8_BAR;
        const LAS int* ix = (const LAS int*)ldsidx;
#pragma unroll
        for (int i = 0; i < 2; ++i) { int R, C; stage_rc(tid * 16 + i * 8192, R, C); cu[0][i] = (unsigned)(ix[R] * RP + C * 2); cu[1][i] = (unsigned)(ix[HALF + R] * RP + C * 2); }
        G8_WAIT_L(0); G8_BAR;
    }
    G8_STAGEB(G8_SB(0, 0), cB); G8_STAGEB(G8_SB(0, 1), cB + hstep); G8_STAGEA(G8_SA(0, 0), cA, 0); G8_STAGEA(G8_SA(0, 1), cA, 1);
    if (wr == 1) G8_BAR;
    G8_WAIT_V(2); G8_BAR;
    G8_STAGEB(G8_SB(1, 0), cB + kstep); G8_STAGEA(G8_SA(1, 0), cA + kstep, 0); G8_STAGEB(G8_SB(1, 1), cB + hstep + kstep);
    G8_WAIT_V(6); G8_BAR;
    for (;;) {
        const bool has_next = S.next(ui + 1, nxt);
        const char* nA = has_next ? S.a_ptr(nxt) : cA; const char* nB = has_next ? S.b_ptr(nxt) : cB;
        if constexpr (GATHER) {
            if (has_next && wid < 4) __builtin_amdgcn_global_load_lds((const unsigned*)(S.idx_ptr(nxt) + wid * 64 + lane), (LAS unsigned*)(ldsidx + ((ui + 1) & 1) * 1024 + wid * 256), 4, 0, 0);
        }
#pragma unroll 1
        for (int t = 0; t < nt; t += 2) {
            const bool last = (t == nt - 2);
            if constexpr (Epi::PREFETCH) { if (t == 2) E.prefetch(cur, lds + 131072, wid); }
            const char* a1 = cA + (size_t)(t + 1) * kstep;
            const char* a2 = last ? nA : cA + (size_t)(t + 2) * kstep; const char* b2 = last ? nB : cB + (size_t)(t + 2) * kstep;
            const char* a3 = a2 + kstep; const char* b3 = b2 + kstep;
            G8_LDB(B0, 0, 0); G8_LDB(B1, 0, 1); G8_SCHED; G8_LDA(At, 0, 0); G8_STAGEA(G8_SA(1, 1), a1, 1);
            G8_WAIT_V(8); G8_WAIT_L(0); G8_BAR; G8_MMA(0, 0, At, B0); G8_MMA(0, 1, At, B1); G8_BAR; G8_SCHED;
            if constexpr (GATHER) {
                if (last && has_next) { const LAS int* ix = (const LAS int*)(ldsidx + ((ui + 1) & 1) * 1024);
#pragma unroll
                    for (int i = 0; i < 2; ++i) { int R, C; stage_rc(tid * 16 + i * 8192, R, C); cu[0][i] = (unsigned)(ix[R] * RP + C * 2); cu[1][i] = (unsigned)(ix[HALF + R] * RP + C * 2); } }
            }
            G8_LDA(At, 0, 1); G8_STAGEB(G8_SB(0, 0), b2); G8_STAGEB(G8_SB(0, 1), b2 + hstep); G8_STAGEA(G8_SA(0, 0), a2, 0);
            G8_WAIT_V(8); G8_WAIT_L(0); G8_BAR; G8_MMA(1, 0, At, B0); G8_MMA(1, 1, At, B1); G8_BAR; G8_SCHED;
            G8_LDB(B0, 1, 0); G8_LDB(B1, 1, 1); G8_SCHED; G8_LDA(At, 1, 0); G8_STAGEA(G8_SA(0, 1), a2, 1);
            G8_WAIT_V(8); G8_WAIT_L(0); G8_BAR; G8_MMA(0, 0, At, B0); G8_MMA(0, 1, At, B1); G8_BAR; G8_SCHED;
            G8_LDA(At, 1, 1); G8_STAGEB(G8_SB(1, 0), b3); G8_STAGEB(G8_SB(1, 1), b3 + hstep); G8_STAGEA(G8_SA(1, 0), a3, 0);
            G8_WAIT_V(8); G8_WAIT_L(0); G8_BAR; G8_MMA(1, 0, At, B0); G8_MMA(1, 1, At, B1); G8_BAR; G8_SCHED;
        }
        if (wr == 0) G8_BAR;
        f32x4 nb[2][2];
        { int t2_ = lane_id(); asm volatile("" : "+v"(t2_));
          if constexpr (Epi::BIAS) E.bias(has_next ? nxt : cur, wc, t2_ >> 4, nb);
          E(acc, cur, wr, wc, t2_ & 15, t2_ >> 4); }
        if (!has_next) break;
#pragma unroll
        for (int a = 0; a < 2; ++a)
#pragma unroll
            for (int b = 0; b < 2; ++b)
#pragma unroll
                for (int m = 0; m < 4; ++m)
#pragma unroll
                    for (int n = 0; n < 2; ++n) { if constexpr (Epi::BIAS) acc[a][b][m][n] = nb[b][n]; else acc[a][b][m][n] = (f32x4){0.f, 0.f, 0.f, 0.f}; }
        cur = nxt; cA = nA; cB = nB; ++ui;
        if (wr == 1) G8_BAR;
    }
    G8_WAIT_V(0);
    G8_BAR;
#undef G8_SA
#undef G8_SB
#undef G8_STAGEA
#undef G8_STAGEA_
#undef G8_DMA
#undef G8_STAGEB
#undef G8_LDA
#undef G8_LDB
#undef G8_MMA
#undef G8_WAIT_V
#undef G8_WAIT_L
#undef G8_BAR
#undef G8_SCHED
}

struct DenseSched {
    const char* A; const char* B; int t0, t1, npn, x, k, gx;
    __device__ __forceinline__ bool next(int i, Unit& u) const {
        const int j = i * gx + k, q = j / npn, rt = t0 + x + 8 * q;
        if (rt >= t1) return false;
        u.rt = rt; u.pn = j - q * npn; u.e = 0; u.row0 = rt * BM; u.nvalid = BM;
        return true;
    }
    __device__ __forceinline__ const char* a_ptr(const Unit& u) const { return A + (size_t)u.rt * (BM * KDIM * 2); }
    __device__ __forceinline__ const char* b_ptr(const Unit& u) const { return B + (size_t)u.pn * (BM * KDIM * 2); }
    __device__ __forceinline__ const int* idx_ptr(const Unit&) const { return nullptr; }
};
}


struct EpiInProj {
    static constexpr bool PERM = true, PREFETCH = true, BIAS = false;
    unsigned char* ws; LAS unsigned char* xr;
    __device__ __forceinline__ void prefetch(const g8::Unit& u, LAS unsigned char* xbuf, int wid) const {
        const int lane = lane_id();
        const unsigned char* src = ws + WS_ROPE + (size_t)u.rt * (256 * 64);
#pragma unroll
        for (int i = 0; i < 2; ++i) { const int pc = wid + 8 * i, P = pc * 64 + lane, row = P >> 2, uu = P & 3;
            dma16(src + (size_t)(row * 4 + (uu ^ ((row >> 2) & 3))) * 16, xbuf + pc * 1024); }
    }
    template <bool GAIN, bool ROPE, int KMODE>
    __device__ __forceinline__ void body(const g8::f32x4 (&acc)[2][2][4][2], const g8::Unit& u, int wr, int fr, int fq, const float* gain, float scale, bf16_t* dst, int pitch) const {
        g8::f32x4 gv[2][2];
        if constexpr (GAIN) {
#pragma unroll
            for (int bj = 0; bj < 2; ++bj)
#pragma unroll
                for (int n = 0; n < 2; ++n) gv[bj][n] = *(const g8::f32x4*)(gain + 32 * bj + 8 * fq + 4 * n) * scale;
        }
#pragma unroll
        for (int ai = 0; ai < 2; ++ai)
#pragma unroll
            for (int m = 0; m < 4; ++m) {
                const int tok = 256 * u.rt + 128 * ai + 64 * wr + 16 * m + fr;
                g8::f32x4 y[2][2];
                if constexpr (GAIN) {
                    float ss = 0.f;
#pragma unroll
                    for (int bj = 0; bj < 2; ++bj)
#pragma unroll
                        for (int n = 0; n < 2; ++n) { const g8::f32x4 v = acc[ai][bj][m][n]; ss += (v[0] * v[0] + v[1] * v[1]) + (v[2] * v[2] + v[3] * v[3]); }
                    { const auto r_ = __builtin_amdgcn_permlane16_swap(__float_as_uint(ss), __float_as_uint(ss), false, false); ss = __uint_as_float(r_[0]) + __uint_as_float(r_[1]); }
                    { const auto r_ = __builtin_amdgcn_permlane32_swap(__float_as_uint(ss), __float_as_uint(ss), false, false); ss = __uint_as_float(r_[0]) + __uint_as_float(r_[1]); }
                    const float rinv = __builtin_amdgcn_rsqf(ss * (1.0f / 64.0f) + NORM_EPS);
#pragma unroll
                    for (int bj = 0; bj < 2; ++bj)
#pragma unroll
                        for (int n = 0; n < 2; ++n) y[bj][n] = acc[ai][bj][m][n] * rinv * gv[bj][n];
                } else {
#pragma unroll
                    for (int bj = 0; bj < 2; ++bj)
#pragma unroll
                        for (int n = 0; n < 2; ++n) y[bj][n] = acc[ai][bj][m][n];
                }
                if constexpr (ROPE) {
                    const int rowu = 128 * ai + 64 * wr + 16 * m + fr;
                    const LAS unsigned char* rbase = (fq < 2) ? xr + rowu * 64 : xr + 16384; const int sw = (fq < 2) ? (rowu >> 2) & 3 : 0;
                    const int uA = (fq & 1) ? 2 : 0, uB = 2 - uA; const unsigned sgnB = (fq == 0) ? 0x80000000u : 0u;
#pragma unroll
                    for (int n = 0; n < 2; ++n) {
                        const g8::f32x4 A4 = *(const LAS g8::f32x4*)(rbase + 16 * ((uA + n) ^ sw)), B4 = *(const LAS g8::f32x4*)(rbase + 16 * ((uB + n) ^ sw));
#pragma unroll
                        for (int e = 0; e < 4; ++e) {
                            const unsigned xm = __float_as_uint(y[0][n][e]);
                            const auto r_ = __builtin_amdgcn_permlane16_swap(xm, xm, false, false);
                            const float lo_ = __uint_as_float(r_[0]), hi_ = __uint_as_float(r_[1]), bs_ = __uint_as_float(__float_as_uint(B4[e]) ^ sgnB);
                            float t_;
                            asm("v_mul_f32 %0, %1, %2" : "=v"(t_) : "v"(hi_), "v"(bs_));
                            asm("v_fmac_f32 %0, %1, %2" : "+v"(t_) : "v"(lo_), "v"(A4[e]));
                            y[0][n][e] = t_;
                        }
                    }
                }
                const int bb = tok >> 11, ss_ = tok & 2047;
                bf16_t* drow; int bjstep;
                if constexpr (KMODE == 0) { drow = dst + (size_t)tok * pitch + 8 * fq; bjstep = 32; }
                else if constexpr (KMODE == 1) { drow = dst + (size_t)bb * 1048576 + (ss_ >> 6) * 4096 + fq * 512 + (ss_ & 63) * 8; bjstep = 2048; }
                else if constexpr (KMODE == 2) { drow = dst + (size_t)bb * 131072 + (ss_ >> 6) * 4096 + fq * 512 + (ss_ & 63) * 8; bjstep = 2048; }
                else { drow = dst + (size_t)bb * 131072 + (ss_ >> 5) * 2048 + fq * 256 + (ss_ & 31) * 8; bjstep = 1024; }
#pragma unroll
                for (int bj = 0; bj < 2; ++bj) {
                    u32x4 w; w.x = cvt_pk_bf16(y[bj][0][0], y[bj][0][1]); w.y = cvt_pk_bf16(y[bj][0][2], y[bj][0][3]);
                    w.z = cvt_pk_bf16(y[bj][1][0], y[bj][1][1]); w.w = cvt_pk_bf16(y[bj][1][2], y[bj][1][3]);
                    *(u32x4*)(drow + bjstep * bj) = w;
                }
                asm volatile("" ::: "memory");
            }
    }
    __device__ __forceinline__ void operator()(const g8::f32x4 (&acc)[2][2][4][2], const g8::Unit& u, int wr, int wc, int fr, int fq) const {
        asm volatile("" : "+v"(fr), "+v"(fq));
        const int g = 4 * u.pn + wc;
        if (g < 8) body<true, true, 0>(acc, u, wr, fr, fq, CF(ws, C_GQA), QSCALE, (bf16_t*)(ws + WS_QA) + g * 64, 512);
        else if (g < 16) body<false, true, 0>(acc, u, wr, fr, fq, nullptr, 1.0f, (bf16_t*)(ws + WS_QI) + (g - 8) * 64, 512);
        else if (g < 24) body<true, true, 0>(acc, u, wr, fr, fq, CF(ws, C_GQB), QSCALE, (bf16_t*)(ws + WS_QB) + (g - 16) * 64, 512);
        else if (g < 32) body<true, true, 1>(acc, u, wr, fr, fq, CF(ws, C_GKB), 1.0f, (bf16_t*)(ws + WS_KB) + (size_t)(g - 24) * 131072, 0);
        else if (g < 40) body<false, false, 0>(acc, u, wr, fr, fq, nullptr, 1.0f, (bf16_t*)(ws + WS_VBT) + (g - 32) * 64, 512);
        else if (g == 40) body<true, true, 2>(acc, u, wr, fr, fq, CF(ws, C_GKA), 1.0f, (bf16_t*)(ws + WS_KA), 0);
        else if (g == 41) body<false, false, 0>(acc, u, wr, fr, fq, nullptr, 1.0f, (bf16_t*)(ws + WS_VAT), 64);
        else if (g == 42) body<true, true, 3>(acc, u, wr, fr, fq, CF(ws, C_GIK), 1.0f, (bf16_t*)(ws + WS_KI), 0);
        else {
#pragma unroll
            for (int ai = 0; ai < 2; ++ai)
#pragma unroll
                for (int m = 0; m < 4; ++m) {
                    const int tok = 256 * u.rt + 128 * ai + 64 * wr + 16 * m + fr;
                    if (fq == 0) { float* wi = (float*)(ws + WS_WI) + (size_t)tok * 8; *(g8::f32x4*)wi = acc[ai][0][m][0] * IW_SCALE; *(g8::f32x4*)(wi + 4) = acc[ai][0][m][1] * IW_SCALE; }
                }
        }
    }
};
__device__ __forceinline__ void p1_inproj_g8(const Ctx& X, const Params& P, LAS unsigned char* ldsall) {
    g8::DenseSched S; S.A = (const char*)(P.ws + WS_H); S.B = (const char*)(P.ws + WS_WIN); S.t0 = 0; S.t1 = T_TOK / 256; S.npn = NGROUP / 4; S.x = X.mx; S.k = X.mk; S.gx = X.nwg >> 3;
    if (X.tid < 16) ((LAS float*)(ldsall + 4096 + 131072 + 16384))[X.tid] = X.tid < 8 ? 1.0f : 0.0f;
    __syncthreads();
    EpiInProj E{P.ws, ldsall + 4096 + 131072};
    g8::gemm_phase<EpiInProj, g8::DenseSched, false>(ldsall + 4096, ldsall + 2048, S, E, X.wid);
}

struct EpiOutProj {
    static constexpr bool PERM = true, PREFETCH = false, BIAS = false;
    const float* x; bf16_t* x1b;
    __device__ __forceinline__ void operator()(const g8::f32x4 (&acc)[2][2][4][2], const g8::Unit& u, int wr, int wc, int fr, int fq) const {
        asm volatile("" : "+v"(fr), "+v"(fq));
        const int row0 = u.rt * 256 + wr * 64 + fr, col0 = u.pn * 256 + wc * 32 + 8 * fq;
#pragma unroll
        for (int ai = 0; ai < 2; ++ai)
#pragma unroll
            for (int m = 0; m < 4; ++m) {
                const size_t ro = (size_t)(row0 + ai * 128 + m * 16) * DM + col0;
#pragma unroll
                for (int bj = 0; bj < 2; ++bj) {
                    const g8::f32x4 v0 = *(const g8::f32x4*)(x + ro + bj * 128) + acc[ai][bj][m][0], v1 = *(const g8::f32x4*)(x + ro + bj * 128 + 4) + acc[ai][bj][m][1];
                    u32x4 w; w.x = cvt_pk_bf16(v0[0], v0[1]); w.y = cvt_pk_bf16(v0[2], v0[3]); w.z = cvt_pk_bf16(v1[0], v1[1]); w.w = cvt_pk_bf16(v1[2], v1[3]);
                    *(u32x4*)(x1b + ro + bj * 128) = w;
                }
            }
    }
};
__device__ __forceinline__ void p3_outproj_g8(const Ctx& X, const Params& P, LAS unsigned char* ldsall) {
    g8::DenseSched S; S.A = (const char*)(P.ws + WS_H); S.B = (const char*)(P.ws + WS_WO); S.t0 = 0; S.t1 = T_TOK / 256; S.npn = 4; S.x = X.mx; S.k = X.mk; S.gx = X.nwg >> 3;
    EpiOutProj E{P.in[0], (bf16_t*)(P.ws + WS_X1B)};
    g8::gemm_phase<EpiOutProj, g8::DenseSched, false>(ldsall + 4096, ldsall + 2048, S, E, X.wid);
}

__device__ __forceinline__ void p4_router(const Ctx& X, const Params& P) {
    unsigned char* ws = P.ws;
    const bf16_t* x1b = (const bf16_t*)(ws + WS_X1B); const float* g = CF(ws, C_GFFN);
    const bf16_t* WR = (const bf16_t*)(ws + WS_WR);
    const float* brt = CF(ws, C_BRT);
    int* topk_e = (int*)(ws + WS_TOPK_E); float* topk_g = (float*)(ws + WS_TOPK_G); int* CNT = (int*)(ws + WS_CNT);
    const int c = X.c, h = X.h, lane = X.lane;
    LAS int* hist = (LAS int*)X.lds;
    for (int wgt = X.wg; wgt < T_TOK / 256; wgt += X.nwg) {
        if (X.tid < 32) hist[X.tid] = 0;
        __syncthreads();
        const int tok0 = wgt * 256 + X.wid * 32;
        f32x4 gv4[4];
#pragma unroll
        for (int i = 0; i < 2; ++i) { gv4[2 * i] = ((const f32x4*)g)[2 * (lane + 64 * i)]; gv4[2 * i + 1] = ((const f32x4*)g)[2 * (lane + 64 * i) + 1]; }
        float myrinv = 0.f;
        for (int r0 = 0; r0 < 32; r0 += 8) {
            u32x4 raw[8][2]; float ss[8];
#pragma unroll
            for (int r = 0; r < 8; ++r)
#pragma unroll
                for (int i = 0; i < 2; ++i) raw[r][i] = *((const u32x4*)(x1b + (size_t)(tok0 + r0 + r) * DM) + lane + 64 * i);
#pragma unroll
            for (int r = 0; r < 8; ++r) { float a = 0.f;
#pragma unroll
                for (int i = 0; i < 2; ++i)
#pragma unroll
                    for (int q = 0; q < 4; ++q) { const float lo = bf_lo(raw[r][i][q]), hi = bf_hi(raw[r][i][q]); a += lo * lo + hi * hi; }
                ss[r] = a; }
#pragma unroll
            for (int o = 32; o >= 1; o >>= 1)
#pragma unroll
                for (int r = 0; r < 8; ++r) ss[r] += __shfl_xor(ss[r], o);
#pragma unroll
            for (int r = 0; r < 8; ++r) {
                const int row = tok0 + r0 + r;
                const float rinv = 1.0f / sqrtf(ss[r] * (1.0f / DM) + NORM_EPS);
                if (c == r0 + r) myrinv = rinv;
#pragma unroll
                for (int i = 0; i < 2; ++i) {
                    float y[8];
#pragma unroll
                    for (int q = 0; q < 4; ++q) { y[2 * q] = bf_lo(raw[r][i][q]) * rinv * gv4[2 * i + (q >> 1)][2 * (q & 1)]; y[2 * q + 1] = bf_hi(raw[r][i][q]) * rinv * gv4[2 * i + (q >> 1)][2 * (q & 1) + 1]; }
                    u32x2 w; w.x = cvt4_fp8(y[0], y[1], y[2], y[3]); w.y = cvt4_fp8(y[4], y[5], y[6], y[7]);
                    *(u32x2*)(ws + WS_H2F8 + (size_t)row * DM + 8 * (lane + 64 * i)) = w;
                }
            }
        }
        f32x16 L = zero16();
        {
            const bf16_t* ap = WR + (size_t)c * DM + 8 * h;
            const bf16_t* bp = x1b + (size_t)(tok0 + c) * DM + 8 * h;
#pragma unroll 4
            for (int k0 = 0; k0 < DM; k0 += 16) {
                const u32x4 raw = *(const u32x4*)(bp + k0);
                L = MFMA32(ldfrag(ap + k0), __builtin_bit_cast(bf16x8, raw), L);
            }
        }
#pragma unroll
        for (int r = 0; r < 16; ++r) L[r] *= myrinv;
        float own[16], oth[16];
#pragma unroll
        for (int r = 0; r < 16; ++r) { own[r] = L[r] + brt[crow(r, h)]; }
#pragma unroll
        for (int r = 0; r < 16; ++r) oth[r] = __shfl_xor(own[r], 32);
        float tv[4]; int te[4];
#pragma unroll
        for (int k = 0; k < 4; ++k) {
            float best = -INFINITY; int bid = 1 << 20;
#pragma unroll
            for (int r = 0; r < 16; ++r) {
                const int e0 = crow(r, h), e1 = crow(r, 1 - h);
                if (own[r] > best || (own[r] == best && e0 < bid)) { best = own[r]; bid = e0; }
                if (oth[r] > best || (oth[r] == best && e1 < bid)) { best = oth[r]; bid = e1; }
            }
            tv[k] = best; te[k] = min(max(bid, 0), 31);
#pragma unroll
            for (int r = 0; r < 16; ++r) { if (crow(r, h) == bid) own[r] = -INFINITY; if (crow(r, 1 - h) == bid) oth[r] = -INFINITY; }
        }
        if (h == 0) {
            const float e0 = 1.0f, e1 = expf(tv[1] - tv[0]), e2 = expf(tv[2] - tv[0]), e3 = expf(tv[3] - tv[0]);
            const float inv = 1.0f / (e0 + e1 + e2 + e3);
            const int tok = tok0 + c;
            *(int4*)(topk_e + (size_t)tok * 4) = make_int4(te[0], te[1], te[2], te[3]);
            f32x4 gg; gg[0] = e0 * inv; gg[1] = e1 * inv; gg[2] = e2 * inv; gg[3] = e3 * inv;
            *(f32x4*)(topk_g + (size_t)tok * 4) = gg;
#pragma unroll
            for (int k = 0; k < 4; ++k) atomicAdd((int*)&hist[te[k]], 1);
        }
        __syncthreads();
        if (X.tid < 32) CNT[wgt * 32 + X.tid] = hist[X.tid];
        __syncthreads();
    }
}

__device__ __forceinline__ void p5_slots(const Ctx& X, const Params& P) {
    unsigned char* ws = P.ws;
    const int* CNT = (const int*)(ws + WS_CNT); int* EXPS = (int*)(ws + WS_EXP);
    const int* topk_e = (const int*)(ws + WS_TOPK_E); int* tokslot = (int*)(ws + WS_TOKSLOT); int* slottok = (int*)(ws + WS_SLOTTOK);
    LAS int* tot = (LAS int*)X.lds;
    LAS int* base = (LAS int*)X.lds + 32;
    LAS int* start = (LAS int*)X.lds + 64;
    LAS int* cur = (LAS int*)X.lds + 128;
    for (int wgt = X.wg; wgt < T_TOK / 256; wgt += X.nwg) {
        __syncthreads();
        {
            LAS int* ptot = (LAS int*)X.lds + 256; LAS int* pbase = (LAS int*)X.lds + 768;
            const int e = X.tid & 31, part = X.tid >> 5;
            int t = 0, bs = 0;
#pragma unroll
            for (int i = 0; i < 16; ++i) { const int w = part * 16 + i; const int v = CNT[w * 32 + e]; t += v; bs += (w < wgt) ? v : 0; }
            ptot[part * 32 + e] = t; pbase[part * 32 + e] = bs;
            __syncthreads();
            if (X.tid < 32) { int tt = 0, bb = 0;
#pragma unroll
                for (int q = 0; q < 16; ++q) { tt += ptot[q * 32 + X.tid]; bb += pbase[q * 32 + X.tid]; }
                tot[X.tid] = tt; base[X.tid] = bb; cur[X.tid] = 0; }
        }
        __syncthreads();
        if (X.tid == 0) { int s = 0; for (int e = 0; e < 32; ++e) { start[e] = s; s += tot[e]; } start[32] = s; }
        __syncthreads();
        if (wgt == 0) {
            if (X.tid < 33) EXPS[X.tid] = start[X.tid];
            if (X.tid < 256) slottok[NSLOT + X.tid] = 0;
        }
        if (X.tid < 256) {
            const int tok = wgt * 256 + X.tid;
            const int4 e4 = *(const int4*)(topk_e + (size_t)tok * 4);
            const int es[4] = {e4.x, e4.y, e4.z, e4.w};
            int sl[4];
#pragma unroll
            for (int k = 0; k < 4; ++k) { const int e = min(max(es[k], 0), 31); const int pos = atomicAdd((int*)&cur[e], 1); sl[k] = min(max(start[e] + base[e] + pos, 0), NSLOT - 1); slottok[sl[k]] = tok; }
            *(int4*)(tokslot + (size_t)tok * 4) = make_int4(sl[0], sl[1], sl[2], sl[3]);
        }
    }
}

constexpr size_t WS_ACT = MIB(208);
template <bool GATHER, int NPN, int PITCH, int BROWS>
struct MoeSched {
    const LAS int* desc;
    const char* A; const char* B; const int* slottok; int t1, x, k, gx;
    __device__ __forceinline__ bool next(int i, g8::Unit& u) const {
        const int j = i * gx + k, q = j / NPN, rt = x + 8 * q;
        if (rt >= t1) return false;
        const int row0 = __builtin_amdgcn_readfirstlane(desc[2 * rt]), info = __builtin_amdgcn_readfirstlane(desc[2 * rt + 1]);
        u.rt = rt; u.pn = j - q * NPN; u.e = info >> 16; u.row0 = row0; u.nvalid = info & 0xffff;
        return true;
    }
    __device__ __forceinline__ const char* a_ptr(const g8::Unit& u) const { return GATHER ? A : A + (size_t)u.row0 * PITCH; }
    __device__ __forceinline__ const char* b_ptr(const g8::Unit& u) const { return B + ((size_t)u.e * BROWS + (size_t)u.pn * 256) * PITCH; }
    __device__ __forceinline__ const int* idx_ptr(const g8::Unit& u) const { return slottok + u.row0; }
};
struct EpiGU {
    static constexpr bool PERM = true, PREFETCH = false, BIAS = true;
    const float* bgu; unsigned char* act; int rb;
    __device__ __forceinline__ void bias(const g8::Unit& u, int wc, int fq, g8::f32x4 (&nb)[2][2]) const {
        const int colbase = 128 * u.pn + 32 * wc + 8 * fq;
#pragma unroll
        for (int n = 0; n < 2; ++n) { nb[0][n] = *(const g8::f32x4*)(bgu + (size_t)u.e * 2048 + colbase + 4 * n); nb[1][n] = *(const g8::f32x4*)(bgu + (size_t)u.e * 2048 + 1024 + colbase + 4 * n) + 1.0f; }
    }
    __device__ __forceinline__ void operator()(const g8::f32x4 (&acc)[2][2][4][2], const g8::Unit& u, int wr, int wc, int fr, int fq) const {
        asm volatile("" : "+v"(fr), "+v"(fq));
        const int colst = 128 * u.pn + 32 * wc + 8 * (fq & ~1);
#pragma unroll
        for (int ai = 0; ai < 2; ++ai)
#pragma unroll
            for (int mp = 0; mp < 4; mp += 2) {
                u32x2 w[2];
#pragma unroll
                for (int q2 = 0; q2 < 2; ++q2) {
                    const int m = mp + q2;
                    float a[8];
                    typedef float f32x2e __attribute__((ext_vector_type(2)));
#pragma unroll
                    for (int n = 0; n < 2; ++n)
#pragma unroll
                        for (int q = 0; q < 4; q += 2) {
                            f32x2e g2 = (f32x2e){acc[ai][0][m][n][q], acc[ai][0][m][n][q + 1]};
                            g2[0] = __builtin_amdgcn_fmed3f(g2[0], -3.0e38f, 7.0f); g2[1] = __builtin_amdgcn_fmed3f(g2[1], -3.0e38f, 7.0f);
                            f32x2e l2 = (f32x2e){acc[ai][1][m][n][q], acc[ai][1][m][n][q + 1]};
                            l2[0] = __builtin_amdgcn_fmed3f(l2[0], -6.0f, 8.0f); l2[1] = __builtin_amdgcn_fmed3f(l2[1], -6.0f, 8.0f);
                            const f32x2e t2 = g2 * -2.4554669595930157f;
                            f32x2e d2 = (f32x2e){__builtin_amdgcn_exp2f(t2[0]), __builtin_amdgcn_exp2f(t2[1])} + 1.0f;
                            const f32x2e s2 = (f32x2e){__builtin_amdgcn_rcpf(d2[0]), __builtin_amdgcn_rcpf(d2[1])};
                            const f32x2e a2 = g2 * s2 * l2;
                            a[4 * n + q] = a2[0]; a[4 * n + q + 1] = a2[1];
                        }
                    w[q2].x = cvt4_fp8(a[0], a[1], a[2], a[3]); w[q2].y = cvt4_fp8(a[4], a[5], a[6], a[7]);
                }
                const auto rx = __builtin_amdgcn_permlane16_swap(w[0].x, w[1].x, false, false), ry = __builtin_amdgcn_permlane16_swap(w[0].y, w[1].y, false, false);
                const int r = 128 * ai + 64 * wr + 16 * (mp + (fq & 1)) + fr;
                if (r < u.nvalid) *(u32x4*)(act + (size_t)(u.row0 - rb + r) * DEXP + colst) = (u32x4){(unsigned)rx[0], (unsigned)ry[0], (unsigned)rx[1], (unsigned)ry[1]};
                asm volatile("" ::: "memory");
            }
    }
};
struct EpiDown {
    static constexpr bool PERM = true, PREFETCH = false, BIAS = true;
    const float* bdn; unsigned char* ys;
    __device__ __forceinline__ void bias(const g8::Unit& u, int wc, int fq, g8::f32x4 (&nb)[2][2]) const {
        const int colbase = 256 * u.pn + 32 * wc + 8 * fq;
#pragma unroll
        for (int bj = 0; bj < 2; ++bj)
#pragma unroll
            for (int n = 0; n < 2; ++n) nb[bj][n] = *(const g8::f32x4*)(bdn + (size_t)u.e * 1024 + colbase + 128 * bj + 4 * n);
    }
    __device__ __forceinline__ void operator()(const g8::f32x4 (&acc)[2][2][4][2], const g8::Unit& u, int wr, int wc, int fr, int fq) const {
        asm volatile("" : "+v"(fr), "+v"(fq));
        const int colst = 256 * u.pn + 32 * wc + 8 * (fq & ~1);
#pragma unroll
        for (int bj = 0; bj < 2; ++bj) {
#pragma unroll
            for (int ai = 0; ai < 2; ++ai)
#pragma unroll
                for (int mp = 0; mp < 4; mp += 2) {
                    u32x2 w[2];
#pragma unroll
                    for (int q2 = 0; q2 < 2; ++q2) { const g8::f32x4 v0 = acc[ai][bj][mp + q2][0], v1 = acc[ai][bj][mp + q2][1];
                        w[q2].x = cvt4_fp8(v0[0], v0[1], v0[2], v0[3]); w[q2].y = cvt4_fp8(v1[0], v1[1], v1[2], v1[3]); }
                    const auto rx = __builtin_amdgcn_permlane16_swap(w[0].x, w[1].x, false, false), ry = __builtin_amdgcn_permlane16_swap(w[0].y, w[1].y, false, false);
                    const int r = 128 * ai + 64 * wr + 16 * (mp + (fq & 1)) + fr;
                    if (r < u.nvalid) *(u32x4*)(ys + (size_t)(u.row0 + r) * DM + colst + 128 * bj) = (u32x4){(unsigned)rx[0], (unsigned)ry[0], (unsigned)rx[1], (unsigned)ry[1]};
                }
            asm volatile("" ::: "memory");
        }
    }
};
constexpr int LDS_TDESC = 4096 + 131072;
#define P6_ROUNDS(X, P, ldsall, bar) do { \
    unsigned char* ws_ = (P).ws; \
    LAS int* es_ = (LAS int*)((ldsall) + 64); LAS int* tp_ = (LAS int*)((ldsall) + 256); LAS int* desc_ = (LAS int*)((ldsall) + LDS_TDESC); \
    __syncthreads(); \
    if ((X).tid < 33) es_[(X).tid] = min(max(((const int*)(ws_ + WS_EXP))[(X).tid], 0), NSLOT); \
    __syncthreads(); \
    if ((X).tid == 0) { int s_ = 0; for (int e_ = 0; e_ < 32; ++e_) { tp_[e_] = s_; s_ += max(es_[e_ + 1] - es_[e_] + 255, 0) >> 8; } tp_[32] = s_; } \
    __syncthreads(); \
    const int ntile_ = min(tp_[32], 1056); \
    for (int t_ = (X).tid; t_ < ntile_; t_ += 512) { int e_ = 0; for (int kk_ = 1; kk_ < 32; ++kk_) if (tp_[kk_] <= t_) e_ = kk_; \
        const int row0_ = es_[e_] + 256 * (t_ - tp_[e_]); desc_[2 * t_] = row0_; desc_[2 * t_ + 1] = (e_ << 16) | min(256, es_[e_ + 1] - row0_); } \
    __syncthreads(); \
    { \
        { MoeSched<true, 8, 1024, 2048> S_; S_.desc = desc_; S_.slottok = (const int*)(ws_ + WS_SLOTTOK); S_.t1 = ntile_; S_.x = (X).mx; S_.k = (X).mk; S_.gx = (X).nwg >> 3; \
          S_.A = (const char*)(ws_ + WS_H2F8); S_.B = (const char*)(ws_ + WS_WGU); \
          EpiGU E_{CF(ws_, C_BGU), ws_ + WS_ACT, 0}; g8::gemm_phase<EpiGU, MoeSched<true, 8, 1024, 2048>, true, true>((ldsall) + 4096, (ldsall) + 2048, S_, E_, (X).wid); } \
        xcd_barrier(bar); \
        { MoeSched<false, 4, 1024, 1024> S_; S_.desc = desc_; S_.slottok = nullptr; S_.t1 = ntile_; S_.x = (X).mx; S_.k = (X).mk; S_.gx = (X).nwg >> 3; \
          S_.A = (const char*)(ws_ + WS_ACT); S_.B = (const char*)(ws_ + WS_WD); \
          EpiDown E_{CF(ws_, C_BDN), ws_ + WS_YS}; g8::gemm_phase<EpiDown, MoeSched<false, 4, 1024, 1024>, false, true>((ldsall) + 4096, (ldsall) + 2048, S_, E_, (X).wid); } \
        xcd_barrier(bar); \
    } } while (0)

__device__ __forceinline__ void p7_combine(const Ctx& X, const Params& P) {
    unsigned char* ws = P.ws;
    const int* tokslot = (const int*)(ws + WS_TOKSLOT); const float* topk_g = (const float*)(ws + WS_TOPK_G); const unsigned char* YS = ws + WS_YS;
    float* out = P.out; const bf16_t* x1b = (const bf16_t*)(ws + WS_X1B);
    typedef float f32x2v __attribute__((ext_vector_type(2)));
    for (int tok = X.gw; tok < T_TOK; tok += X.nw) {
        const int4 sl = *(const int4*)(tokslot + (size_t)tok * 4); const f32x4 gg = *(const f32x4*)(topk_g + (size_t)tok * 4);
        const int s4[4] = {min(max(sl.x, 0), NSLOT - 1), min(max(sl.y, 0), NSLOT - 1), min(max(sl.z, 0), NSLOT - 1), min(max(sl.w, 0), NSLOT - 1)};
#pragma unroll
        for (int half = 0; half < 2; ++half) {
            const int col = half * 512 + X.lane * 8;
            const u32x4 xw = __builtin_nontemporal_load((const u32x4*)(x1b + (size_t)tok * DM + col));
            f32x4 o0, o1; o0[0] = bf_lo(xw.x); o0[1] = bf_hi(xw.x); o0[2] = bf_lo(xw.y); o0[3] = bf_hi(xw.y); o1[0] = bf_lo(xw.z); o1[1] = bf_hi(xw.z); o1[2] = bf_lo(xw.w); o1[3] = bf_hi(xw.w);
#pragma unroll
            for (int k = 0; k < 4; ++k) {
                const u32x2 y = __builtin_nontemporal_load((const u32x2*)(YS + (size_t)s4[k] * DM + col)); const float gk = gg[k];
                const f32x2v a = __builtin_amdgcn_cvt_pk_f32_fp8((int)y.x, false), b = __builtin_amdgcn_cvt_pk_f32_fp8((int)y.x, true);
                const f32x2v c = __builtin_amdgcn_cvt_pk_f32_fp8((int)y.y, false), d = __builtin_amdgcn_cvt_pk_f32_fp8((int)y.y, true);
                o0[0] += gk * a[0]; o0[1] += gk * a[1]; o0[2] += gk * b[0]; o0[3] += gk * b[1];
                o1[0] += gk * c[0]; o1[1] += gk * c[1]; o1[2] += gk * d[0]; o1[3] += gk * d[1];
            }
            __builtin_nontemporal_store(o0, (f32x4*)(out + (size_t)tok * DM + col)); __builtin_nontemporal_store(o1, (f32x4*)(out + (size_t)tok * DM + col + 4));
        }
    }
}

constexpr int LDS_BYTES = 155648;
__global__ void __launch_bounds__(512, 2) fwd(Params P) {
    extern __shared__ __attribute__((aligned(16))) unsigned char lds[];
    const int wid0_ = __builtin_amdgcn_readfirstlane((int)threadIdx.x >> 6);
    if (threadIdx.x == 0) *(LAS u32x4*)lds = (u32x4){0u, 0u, 0u, 0u};
    __syncthreads();
    (void)xcd_barrier_post((unsigned*)(P.ws + WS_BAR), (volatile LAS unsigned*)lds, threadIdx.x == 0);
    if (threadIdx.x == 0) { const unsigned xc = xb_xcc_id(); ((LAS unsigned*)lds)[4] = xc; ((LAS unsigned*)lds)[5] = xb_add((unsigned*)(P.ws + WS_XRANK) + 64 * xc, 1u); }
#define xcd_barrier(b) xcd_barrier_((b), wid0_ == 0 && lane_id() == 0)
#define bar (XcdBarrier{(unsigned*)(P.ws + WS_BAR), xb_xcc_id(), (volatile LAS unsigned*)lds})
    Ctx X;
#define NEW_CTX() do { int l_ = lane_id(); asm volatile("" : "+v"(l_));     \
    X.lane = l_; X.wid = wid0_; X.tid = wid0_ * 64 + l_; X.c = X.lane & 31; X.h = X.lane >> 5; \
    X.wg = blockIdx.x; X.nwg = gridDim.x; X.gw = X.wg * 8 + X.wid; X.nw = X.nwg * 8; X.lds = (LAS unsigned char*)lds + 64; \
    { const LAS unsigned* m_ = (const LAS unsigned*)lds; const bool hw_ = (m_[2] != 0u) && (m_[4] < 8u) && (m_[5] < m_[0]);     \
      X.mx = __builtin_amdgcn_readfirstlane(hw_ ? (int)m_[4] : (X.wg & 7)); X.mk = __builtin_amdgcn_readfirstlane(hw_ ? (int)m_[5] : (X.wg >> 3)); } } while (0)

    NEW_CTX();
    p0_prologue(X, P);
    xcd_barrier(bar);
    NEW_CTX();
    p1_inproj_g8(X, P, (LAS unsigned char*)lds);
    xcd_barrier(bar);
    NEW_CTX();
    p2_mixers(X, P, (LAS unsigned char*)lds);
    xcd_barrier(bar);
    NEW_CTX();
    p3_outproj_g8(X, P, (LAS unsigned char*)lds);
    xcd_barrier(bar);
    NEW_CTX();
    p4_router(X, P);
    xcd_barrier(bar);
    NEW_CTX();
    p5_slots(X, P);
    xcd_barrier(bar);
    NEW_CTX();
    P6_ROUNDS(X, P, (LAS unsigned char*)lds, bar);
    NEW_CTX();
    p7_combine(X, P);
}

extern "C" void kernel_launch(void* const* d_in, const int* in_sizes, int n_in, void* d_out, int out_size, void* d_ws, size_t ws_size, hipStream_t stream) {
    static int grid = 0;
    if (grid == 0) {
        if (n_in != 22 || out_size != T_TOK * DM || ws_size < WS_END) { fprintf(stderr, "kernel_launch: unexpected shapes (n_in %d out %d ws %zu)\n", n_in, out_size, ws_size); grid = -1; return; }
        int dev = 0, cus = 0, per_cu = 0;
        if (hipGetDevice(&dev) != hipSuccess || hipDeviceGetAttribute(&cus, hipDeviceAttributeMultiprocessorCount, dev) != hipSuccess) { grid = -1; return; }
        if (hipFuncSetAttribute((const void*)fwd, hipFuncAttributeMaxDynamicSharedMemorySize, LDS_BYTES) != hipSuccess) { fprintf(stderr, "kernel_launch: hipFuncSetAttribute failed\n"); grid = -1; return; }
        if (hipOccupancyMaxActiveBlocksPerMultiprocessor(&per_cu, (const void*)fwd, 512, LDS_BYTES) != hipSuccess || per_cu < 1) { fprintf(stderr, "kernel_launch: occupancy query says %d\n", per_cu); }
        (void)hipGetLastError();
        grid = cus;
    }
    if (grid < 0) return;
    (void)hipMemsetAsync(d_ws, 0, 24576, stream);
    Params p{};
    for (int i = 0; i < 22; ++i) p.in[i] = (const float*)d_in[i];
    p.out = (float*)d_out; p.ws = (unsigned char*)d_ws;
    hipLaunchKernelGGL(fwd, dim3(grid), dim3(512), LDS_BYTES, stream, p);
}
```

```cpp
#include <hip/hip_runtime.h>
#include <stdint.h>
#include <stdio.h>

typedef unsigned short bf16_t;
typedef short bf16x8 __attribute__((ext_vector_type(8)));
typedef short s16x4 __attribute__((ext_vector_type(4)));
typedef float f32x16 __attribute__((ext_vector_type(16)));
typedef float f32x4 __attribute__((ext_vector_type(4)));
typedef unsigned u32x4 __attribute__((ext_vector_type(4)));
typedef unsigned u32x2 __attribute__((ext_vector_type(2)));

constexpr int T_TOK = 65536, DM = 1024, SEQ = 2048, NBATCH = 32;
constexpr int NGROUP = 44;
constexpr int NEXP = 32, DEXP = 1024;
constexpr int NSLOT = T_TOK * 4;
constexpr float NORM_EPS = 1e-6f;
constexpr float QSCALE = 0.125f * 1.4426950408889634f;
constexpr float IW_SCALE = 0.04419417382415922f;
constexpr float LAM_INIT = 0.2f;

#define MIB(x) ((size_t)(x) << 20)
constexpr size_t WS_BAR = 0;
constexpr size_t WS_XRANK = 16384;
constexpr size_t WS_CNT = 65536;
constexpr size_t WS_EXP = 65536 + 32768;
constexpr size_t WS_CONST = 524288;
constexpr int C_BGU = 0, C_BDN = 65536, C_GQA = 98304, C_GKA = C_GQA + 64, C_GIK = C_GQA + 128, C_LQ1 = C_GQA + 192, C_LK1 = C_GQA + 256, C_LQ2 = C_GQA + 320,
              C_LK2 = C_GQA + 384, C_GQB = C_GQA + 448, C_GKB = C_GQA + 512, C_GSUB = C_GQA + 576, C_GFFN = C_GQA + 704, C_BRT = C_GQA + 1728, C_END = C_GQA + 1760;
constexpr size_t WS_TOPK_E = MIB(1);
constexpr size_t WS_TOPK_G = MIB(2);
constexpr size_t WS_TOKSLOT = MIB(3);
constexpr size_t WS_ROPE = MIB(4);
constexpr size_t WS_SLOTTOK = MIB(4);
constexpr size_t WS_WGU = MIB(8);
constexpr size_t WS_WD = MIB(72);
constexpr size_t WS_H2F8 = MIB(104);
constexpr size_t WS_WIN = MIB(200);
constexpr size_t WS_WR = MIB(200) + 5767168;
constexpr size_t WS_WO = MIB(206);
constexpr size_t WS_H = MIB(208);
constexpr size_t WS_QA = MIB(336);
constexpr size_t WS_QI = MIB(400);
constexpr size_t WS_QB = MIB(464);
constexpr size_t WS_KB = MIB(528);
constexpr size_t WS_VBT = MIB(592);
constexpr size_t WS_KA = MIB(656);
constexpr size_t WS_VAT = MIB(664);
constexpr size_t WS_KI = MIB(672);
constexpr size_t WS_WI = MIB(680);
constexpr size_t WS_YS = MIB(512);
constexpr size_t WS_X1B = MIB(768);
constexpr size_t WS_END = MIB(1024);

#define XB_TMO      128
#define XB_XCNT(j)  (256  + 64 * (j))
#define XB_XSUB(j)  (1280 + 64 * (j))
#define XB_XGEN(j)  (2304 + 64 * (j))
#define XB_TOP      3328
#define XB_TOPGEN   3392
#define XCD_BAR_WORDS 3456
#define XB_SPIN_CAP (1u << 18)
#define LAS __attribute__((address_space(3)))

__device__ __forceinline__ unsigned xb_ld(unsigned* p)              { return __hip_atomic_load(p, __ATOMIC_RELAXED, __HIP_MEMORY_SCOPE_AGENT); }
__device__ __forceinline__ unsigned xb_add(unsigned* p, unsigned v) { return __hip_atomic_fetch_add(p, v, __ATOMIC_RELAXED, __HIP_MEMORY_SCOPE_AGENT); }
__device__ __forceinline__ unsigned xb_xcc_id() { return (unsigned)__builtin_amdgcn_s_getreg((3 << 11) | 20) & 0xFu; }
#define XB_SPIN(cond, bar) do { unsigned _sp = 0; while (cond) { __builtin_amdgcn_s_sleep(1); \
    if ((++_sp & 255u) == 0u) { if (xb_ld(&(bar)[XB_TMO])) break; if (_sp > XB_SPIN_CAP) { atomicAdd(&(bar)[XB_TMO], 1u); break; } } } } while (0)

struct XcdBarrier { unsigned* bar; unsigned x; volatile LAS unsigned* st; };

__device__ __forceinline__ XcdBarrier xcd_barrier_post(unsigned* bar, volatile LAS unsigned* st, bool t0  ) {
    XcdBarrier b; b.bar = bar; b.x = xb_xcc_id(); b.st = st;
    if (t0) (void)xb_add(&bar[XB_XCNT(b.x)], 1u);
    return b;
}
__device__ __forceinline__ bool xcd_barrier_complete(unsigned* bar, unsigned x, unsigned& nloc, unsigned& nx) {
    const unsigned G = gridDim.x * gridDim.y * gridDim.z;
    unsigned sum, cnt, mine, sp = 0u; bool uni;
    for (;;) {
        sum = 0u; cnt = 0u; mine = 0u; uni = true;
#pragma unroll
        for (unsigned j = 0; j < 16; ++j) { const unsigned c = xb_ld(&bar[XB_XCNT(j)]); sum += c; cnt += (c > 0u) ? 1u : 0u; mine = (j == x) ? c : mine; uni = uni && (c == 0u || c * 8u == G); }
        if (sum == G) break;
        __builtin_amdgcn_s_sleep(1);
        if ((++sp & 255u) == 0u) { if (xb_ld(&bar[XB_TMO])) break; if (sp > XB_SPIN_CAP) { atomicAdd(&bar[XB_TMO], 1u); break; } }
    }
    nloc = mine > 0u ? mine : 1u; nx = cnt > 0u ? cnt : 1u;
    return sum == G && cnt == 8u && uni;
}
__device__ __forceinline__ void xcd_barrier_(const XcdBarrier& b, bool t0  ) {
    asm volatile("s_waitcnt vmcnt(0)" ::: "memory");
    __syncthreads();
    if (t0) {
        unsigned* bar = b.bar;
        __builtin_amdgcn_s_waitcnt(0);
        unsigned nloc = b.st[0], nx = b.st[1];
        if (nloc == 0u) { const bool uni = xcd_barrier_complete(bar, b.x, nloc, nx); b.st[0] = nloc; b.st[1] = nx; b.st[2] = uni ? 1u : 0u; }
        const unsigned old = xb_add(&bar[XB_XSUB(b.x)], 1u);
        const unsigned gen = old / nloc;
        if (old + 1u == (gen + 1u) * nloc) {
            __builtin_amdgcn_fence(__ATOMIC_RELEASE, "agent");
            asm volatile("s_waitcnt vmcnt(0)" ::: "memory");
            const unsigned og = xb_add(&bar[XB_TOP], 1u);
            const unsigned tg = og / nx;
            if (og + 1u == (tg + 1u) * nx) xb_add(&bar[XB_TOPGEN], 1u);
            else XB_SPIN(xb_ld(&bar[XB_TOPGEN]) == tg, bar);
            __builtin_amdgcn_fence(__ATOMIC_ACQUIRE, "agent");
            xb_add(&bar[XB_XGEN(b.x)], 1u);
            asm volatile("s_waitcnt vmcnt(0)" ::: "memory");
        } else {
            XB_SPIN(xb_ld(&bar[XB_XGEN(b.x)]) == gen, bar);
            __builtin_amdgcn_fence(__ATOMIC_ACQUIRE, "agent");
            asm volatile("s_waitcnt vmcnt(0)" ::: "memory");
        }
    }
    __syncthreads();
}

#define MFMA32(a, b, c) __builtin_amdgcn_mfma_f32_32x32x16_bf16((a), (b), (c), 0, 0, 0)
__device__ __forceinline__ int crow(int r, int h) { return (r & 3) + 8 * (r >> 2) + 4 * h; }
typedef __bf16 bf16x2_t __attribute__((ext_vector_type(2)));
typedef float f32x2_t __attribute__((ext_vector_type(2)));
__device__ __forceinline__ unsigned cvt_pk_bf16(float lo, float hi) { f32x2_t v; v.x = lo; v.y = hi; return __builtin_bit_cast(unsigned, __builtin_convertvector(v, bf16x2_t)); }

typedef int v8i32 __attribute__((ext_vector_type(8)));
constexpr float W8_SCALE = 32.0f;
constexpr int W8_E8M0 = 127 - 5, ONE_E8M0 = 127;
__device__ __forceinline__ unsigned cvt4_fp8(float a, float b, float c, float d) { int w = __builtin_amdgcn_cvt_pk_fp8_f32(a, b, 0, false); w = __builtin_amdgcn_cvt_pk_fp8_f32(c, d, w, true); return (unsigned)w; }
__device__ __forceinline__ float wave_sum(float v) {
#pragma unroll
    for (int o = 32; o >= 1; o >>= 1) v += __shfl_xor(v, o);
    return v;
}
__device__ __forceinline__ bf16x8 ldfrag(const bf16_t* p) { return *reinterpret_cast<const bf16x8*>(p); }
__device__ __forceinline__ bf16x8 pack8(const f32x16& v, int base) {
    u32x4 w; w.x = cvt_pk_bf16(v[base + 0], v[base + 1]); w.y = cvt_pk_bf16(v[base + 2], v[base + 3]);
    w.z = cvt_pk_bf16(v[base + 4], v[base + 5]); w.w = cvt_pk_bf16(v[base + 6], v[base + 7]);
    return __builtin_bit_cast(bf16x8, w);
}
__device__ __forceinline__ f32x16 zero16() { f32x16 z;
#pragma unroll
    for (int i = 0; i < 16; ++i) z[i] = 0.f; return z; }


struct Params {
    const float* in[22];
    float* out;
    unsigned char* ws;
};

#define CF(ws, off) ((const float*)((ws) + WS_CONST) + (off))

__device__ __forceinline__ int lane_id() { unsigned z = 0; asm volatile("" : "+v"(z));
    return (int)__builtin_amdgcn_mbcnt_hi(~0u, __builtin_amdgcn_mbcnt_lo(~0u, z)); }

__device__ __forceinline__ float bf_lo(unsigned w) { return __uint_as_float(w << 16); }
__device__ __forceinline__ float bf_hi(unsigned w) { return __uint_as_float(w & 0xffff0000u); }
struct Ctx {
    int tid, lane, wid, c, h, gw, nw, wg, nwg, mx, mk;
    LAS unsigned char* lds;
};

__device__ __forceinline__ void p0_rmsnorm_rows(const Ctx& X, const float* __restrict__ x, const float* __restrict__ g, bf16_t* __restrict__ H) {
    f32x4 gv[4];
#pragma unroll
    for (int i = 0; i < 4; ++i) gv[i] = ((const f32x4*)g)[X.lane + 64 * i];
    for (int base = X.gw * 4; base < T_TOK; base += X.nw * 4) {
        f32x4 v[4][4]; float ss[4];
#pragma unroll
        for (int r = 0; r < 4; ++r)
#pragma unroll
            for (int i = 0; i < 4; ++i) v[r][i] = __builtin_nontemporal_load((const f32x4*)(x + (size_t)(base + r) * DM) + X.lane + 64 * i);
#pragma unroll
        for (int r = 0; r < 4; ++r) { float a = 0.f;
#pragma unroll
            for (int i = 0; i < 4; ++i) a += v[r][i][0] * v[r][i][0] + v[r][i][1] * v[r][i][1] + v[r][i][2] * v[r][i][2] + v[r][i][3] * v[r][i][3];
            ss[r] = a; }
#pragma unroll
        for (int o = 32; o >= 1; o >>= 1)
#pragma unroll
            for (int r = 0; r < 4; ++r) ss[r] += __shfl_xor(ss[r], o);
#pragma unroll
        for (int r = 0; r < 4; ++r) {
            const float rinv = 1.0f / sqrtf(ss[r] * (1.0f / DM) + NORM_EPS);
#pragma unroll
            for (int i = 0; i < 4; ++i) {
                u32x2 w; w.x = cvt_pk_bf16(v[r][i][0] * rinv * gv[i][0], v[r][i][1] * rinv * gv[i][1]); w.y = cvt_pk_bf16(v[r][i][2] * rinv * gv[i][2], v[r][i][3] * rinv * gv[i][3]);
                *(u32x2*)(H + (size_t)(base + r) * DM + 4 * (X.lane + 64 * i)) = w;
            }
        }
    }
}

__device__ __forceinline__ void transpose_tile(const Ctx& X, const float* __restrict__ src, int ldsrc, int c0, int nvalid, int k0, bf16_t* __restrict__ dst, int ldd, int n0, int n0b = -1, const float* __restrict__ kscale = nullptr) {
    LAS float* tile = (LAS float*)X.lds;
    const int col = X.tid & 63, r0 = X.tid >> 6;
#pragma unroll
    for (int i = 0; i < 8; ++i) { const int row = r0 + 8 * i; float t_ = (col < nvalid) ? __builtin_nontemporal_load(src + (size_t)(k0 + row) * ldsrc + c0 + col) : 0.f; if (kscale) t_ *= kscale[k0 + row]; tile[row * 65 + col] = t_; }
    __syncthreads();
    const int nrow = X.tid >> 3, kseg = X.tid & 7;
    float v[8];
#pragma unroll
    for (int k = 0; k < 8; ++k) v[k] = tile[(kseg * 8 + k) * 65 + nrow];
    u32x4 w; w.x = cvt_pk_bf16(v[0], v[1]); w.y = cvt_pk_bf16(v[2], v[3]); w.z = cvt_pk_bf16(v[4], v[5]); w.w = cvt_pk_bf16(v[6], v[7]);
    const int drow = (n0b >= 0 && nrow >= 32) ? (n0b + nrow - 32) : (n0 + nrow);
    *(u32x4*)(dst + (size_t)drow * ldd + k0 + kseg * 8) = w;
    __syncthreads();
}

__device__ __forceinline__ void transpose_tile8(const Ctx& X, const float* __restrict__ src, int ldsrc, int c0, int k0, unsigned char* __restrict__ dst8, int ldd, int n0) {
    LAS float* tile = (LAS float*)X.lds;
    const int col = X.tid & 63, r0 = X.tid >> 6;
#pragma unroll
    for (int i = 0; i < 8; ++i) { const int row = r0 + 8 * i; tile[row * 65 + col] = __builtin_nontemporal_load(src + (size_t)(k0 + row) * ldsrc + c0 + col); }
    __syncthreads();
    const int nrow = X.tid >> 3, kseg = X.tid & 7;
    float v[8];
#pragma unroll
    for (int k = 0; k < 8; ++k) v[k] = tile[(kseg * 8 + k) * 65 + nrow] * W8_SCALE;
    u32x2 w; w.x = cvt4_fp8(v[0], v[1], v[2], v[3]); w.y = cvt4_fp8(v[4], v[5], v[6], v[7]);
    *(u32x2*)(dst8 + (size_t)(n0 + nrow) * ldd + k0 + kseg * 8) = w;
    __syncthreads();
}
__device__ __forceinline__ void win_group_src(int g, int& c0, int& nvalid) {
    nvalid = 64;
    if (g < 8) c0 = 64 * g;
    else if (g < 16) c0 = 640 + 64 * (g - 8);
    else if (g < 24) c0 = 1224 + 64 * (g - 16);
    else if (g < 32) c0 = 1736 + 64 * (g - 24);
    else if (g < 40) c0 = 2248 + 64 * (g - 32);
    else if (g == 40) c0 = 512;
    else if (g == 41) c0 = 576;
    else if (g == 42) c0 = 1152;
    else { c0 = 1216; nvalid = 8; }
}

__device__ __forceinline__ void p0_prologue(const Ctx& X, const Params& P) {
    unsigned char* ws = P.ws;
    {
        float* cst = (float*)(ws + WS_CONST);
        for (int i = X.wg * 512 + X.tid; i < C_END; i += X.nwg * 512) {
            float v;
            if (i < C_BDN) v = P.in[19][i];
            else if (i < C_GQA) v = P.in[21][i - C_BDN];
            else if (i < C_GKA) v = P.in[4][i - C_GQA];
            else if (i < C_GIK) v = P.in[5][i - C_GKA];
            else if (i < C_LQ1) v = P.in[6][i - C_GIK];
            else if (i < C_LK1) v = P.in[7][i - C_LQ1];
            else if (i < C_LQ2) v = P.in[8][i - C_LK1];
            else if (i < C_LK2) v = P.in[9][i - C_LQ2];
            else if (i < C_GQB) v = P.in[10][i - C_LK2];
            else if (i < C_GKB) v = P.in[11][i - C_GQB];
            else if (i < C_GSUB) v = P.in[12][i - C_GKB];
            else if (i < C_GFFN) v = P.in[13][i - C_GSUB];
            else if (i < C_BRT) v = P.in[15][i - C_GFFN];
            else v = P.in[17][i - C_BRT];
            cst[i] = v;
        }
    }
    p0_rmsnorm_rows(X, P.in[0], P.in[2], (bf16_t*)(ws + WS_H));
    {
        const int* pos = (const int*)P.in[1]; float* rope = (float*)(ws + WS_ROPE);
        for (int idx = X.wg * 512 + X.tid; idx < T_TOK * 8; idx += X.nwg * 512) {
            const int tok = idx >> 3, i = idx & 7;
            const float invf = i == 0 ? 1.0f : i == 1 ? 0.1939227432012558f : i == 2 ? 0.03760603070259094f : i == 3 ? 0.007292664609849453f : i == 4 ? 0.0014142135623842478f
                             : i == 5 ? 0.00027424818836152554f : i == 6 ? 5.3182957344688475e-05f : 1.0313385246263351e-05f;
            const float ang = (float)pos[tok] * invf;
            rope[tok * 16 + i] = cosf(ang); rope[tok * 16 + 8 + i] = sinf(ang);
        }
    }
    {
        const int ntile = 32 * 32 * 16;
        for (int t = X.wg; t < ntile; t += X.nwg) {
            const int kt = t & 15, q = (t >> 4) & 31, e = t >> 9;
            const int u = q >> 2, w = q & 3; const int c0 = (w < 2) ? (128 * u + 64 * w) : (1024 + 128 * u + 64 * (w - 2));
            transpose_tile8(X, P.in[18] + (size_t)e * 1024 * 2048, 2048, c0, kt * 64, ws + WS_WGU + (size_t)e * 2048 * 1024, 1024, q * 64);
        }
    }
    {
        const int ntile = 32 * 16 * 16;
        for (int t = X.wg; t < ntile; t += X.nwg) {
            const int kt = t & 15, q = (t >> 4) & 15, e = t >> 8;
            transpose_tile8(X, P.in[20] + (size_t)e * 1024 * 1024, 1024, q * 64, kt * 64, ws + WS_WD + (size_t)e * 1024 * 1024, 1024, q * 64);
        }
    }
    {
        const int ntile = NGROUP * 16;
        for (int t = X.wg; t < ntile; t += X.nwg) {
            const int kt = t & 15, g = t >> 4; int c0, nv; win_group_src(g, c0, nv);
            transpose_tile(X, P.in[3], 2760, c0, nv, kt * 64, (bf16_t*)(ws + WS_WIN), 1024, 256 * (g >> 2) + 32 * (g & 3), 256 * (g >> 2) + 128 + 32 * (g & 3));
        }
    }
    {
        for (int t = X.wg; t < 256; t += X.nwg) { const int kt = t & 15, q = t >> 4; transpose_tile(X, P.in[14], 1024, q * 64, 64, kt * 64, (bf16_t*)(ws + WS_WO), 1024, q * 64); }
    }
    {
        for (int t = X.wg; t < 16; t += X.nwg) transpose_tile(X, P.in[16], 32, 0, 32, t * 64, (bf16_t*)(ws + WS_WR), 1024, 0, -1, P.in[15]);
    }
}

typedef short v4i16_t __attribute__((ext_vector_type(4)));
__device__ __forceinline__ s16x4 tr16(const LAS unsigned char* p) { return __builtin_bit_cast(s16x4, __builtin_amdgcn_ds_read_tr16_b64_v4i16((LAS v4i16_t*)p)); }
__device__ __forceinline__ void dma16(const void* g, LAS unsigned char* l) {
    const unsigned base = (unsigned)__builtin_amdgcn_readfirstlane((int)(unsigned)(uintptr_t)l); unsigned sv;
    asm volatile("s_mov_b32 %0, m0\n\ts_mov_b32 m0, %2\n\ts_nop 0\n\tglobal_load_lds_dwordx4 %1, off\n\ts_mov_b32 m0, %0" : "=&s"(sv) : "v"(g), "s"(base) : "memory"); }
__device__ __forceinline__ bf16x8 ldsfrag(const LAS unsigned char* p) { return *(const LAS bf16x8*)p; }
constexpr int L2_FB = 1024, L2_CB = 5120, L2_ZM = 9216  , L2_WL = 17408, L2_ZT = 18432, L2_QI = 20480, L2_M8 = 20480  ,
              L2_XB = 20480  , L2_KIW = 53248  , L2_KVB = 86016  , L2_DIFF = 20480;


__device__ __forceinline__ void count_ge4(int& c0, int& c1, float x0, float x1, float x2, float x3, float t) {
    unsigned long long m0, m1, m2, m3;
    asm volatile("v_cmp_ge_f32_e64 %2, %6, %10\n\tv_cmp_ge_f32_e64 %3, %7, %10\n\tv_cmp_ge_f32_e64 %4, %8, %10\n\tv_cmp_ge_f32_e64 %5, %9, %10\n\t"
                 "v_addc_co_u32_e64 %0, vcc, 0, %0, %2\n\tv_addc_co_u32_e64 %1, vcc, 0, %1, %3\n\tv_addc_co_u32_e64 %0, vcc, 0, %0, %4\n\tv_addc_co_u32_e64 %1, vcc, 0, %1, %5"
                 : "+v"(c0), "+v"(c1), "=&s"(m0), "=&s"(m1), "=&s"(m2), "=&s"(m3) : "v"(x0), "v"(x1), "v"(x2), "v"(x3), "v"(t) : "vcc");
}

__device__ __forceinline__ void dsa_unit(const Ctx& X, const Params& P, LAS unsigned char* ldsall, int b, int qt) {
    unsigned char* ws = P.ws;
    const bf16_t* QI = (const bf16_t*)(ws + WS_QI); const bf16_t* KI = (const bf16_t*)(ws + WS_KI); const float* WI = (const float*)(ws + WS_WI);
    const bf16_t* QA = (const bf16_t*)(ws + WS_QA); const bf16_t* KA = (const bf16_t*)(ws + WS_KA); const bf16_t* VA = (const bf16_t*)(ws + WS_VAT);
    bf16_t* Y = (bf16_t*)(ws + WS_H);
    const int wid = X.wid, lane = lane_id(), c = lane & 31, h = lane >> 5;
    const int q0 = qt * 32, chunk = q0 >> 6, nkb = 2 * (chunk + 1);
    const int tokq = b * SEQ + q0 + c;
    LAS float* fb = (LAS float*)(ldsall + L2_FB);
    LAS int* cb = (LAS int*)(ldsall + L2_CB);
    LAS unsigned char* m8 = ldsall + L2_M8;
    LAS unsigned char* qis = ldsall + L2_QI;
    LAS unsigned char* kv = ldsall + L2_KVB;
#define KVSLOT(tt) (kv + (((tt) + 2) % 3) * 16384)
    __syncthreads();
    const bf16_t* ksrc = KA + (size_t)b * 131072 + wid * 512 + lane * 8;
    const bf16_t* vsrc = VA + (size_t)(b * SEQ + 16 * (wid & 3) + (lane >> 2)) * 64 + (wid >> 2) * 32 + (lane & 3) * 8;
    dma16(ksrc, KVSLOT(0) + wid * 1024); dma16(vsrc, KVSLOT(0) + 8192 + wid * 1024);
    if (nkb <= 8) {
        *(LAS u32x4*)(m8 + (wid * 64 + lane) * 16) = (u32x4){0u, 0u, 0u, 0u};
    } else {
        LAS float* wl = (LAS float*)(ldsall + L2_WL);
        if (wid == 0 && h == 0) { *(LAS f32x4*)(wl + c * 8) = *(const f32x4*)(WI + (size_t)tokq * 8); *(LAS f32x4*)(wl + c * 8 + 4) = *(const f32x4*)(WI + (size_t)tokq * 8 + 4); }
#pragma unroll
        for (int i = 0; i < 4; ++i) { const int piece = wid * 4 + i, head = piece >> 2, cp = piece & 3;
            dma16(QI + (size_t)(b * SEQ + q0 + (lane & 31)) * 512 + head * 64 + (2 * cp + (lane >> 5)) * 8, qis + piece * 1024); }
        asm volatile("s_waitcnt vmcnt(0)" ::: "memory");
        __syncthreads();
        f32x16 sc[8];
        LAS unsigned char* kiw = ldsall + L2_KIW + wid * 8192;
        const bf16_t* kisrc = KI + (size_t)b * 131072 + lane * 8;
#define KI_DMA(kb_, buf_) do { _Pragma("unroll") for (int j_ = 0; j_ < 4; ++j_) dma16(kisrc + (size_t)(kb_) * 2048 + 512 * j_, kiw + (buf_) * 4096 + j_ * 1024); } while (0)
        KI_DMA(wid, 0);
#pragma unroll
        for (int i = 0; i < 8; ++i) {
            const int kb = wid + 8 * i;
            f32x16 a = zero16();
            if (kb < nkb) {
                if (i < 7 && kb + 8 < nkb) { KI_DMA(kb + 8, (i + 1) & 1); asm volatile("s_waitcnt vmcnt(4)" ::: "memory"); }
                else asm volatile("s_waitcnt vmcnt(0)" ::: "memory");
                const LAS unsigned char* kbuf = kiw + (i & 1) * 4096;
                bf16x8 kf[4];
#pragma unroll
                for (int s = 0; s < 4; ++s) kf[s] = ldsfrag(kbuf + (2 * s + h) * 512 + c * 16);
                float wcur = wl[c * 8];
#pragma unroll 1
                for (int hd = 0; hd < 8; ++hd) {
                    const float wnext = wl[c * 8 + ((hd + 1) & 7)];
                    f32x16 S = zero16();
#pragma unroll
                    for (int s = 0; s < 4; ++s) S = MFMA32(kf[s], ldsfrag(qis + hd * 4096 + (2 * s + h) * 512 + c * 16), S);
#pragma unroll
                    for (int r = 0; r < 16; ++r) { const float rl = __builtin_amdgcn_fmed3f(S[r], 0.0f, 3.0e38f);
                        asm("v_fmac_f32 %0, %1, %2" : "+v"(a[r]) : "v"(wcur), "v"(rl)); }
                    wcur = wnext;
                }
            } else {
#pragma unroll
                for (int r = 0; r < 16; ++r) a[r] = -INFINITY;
            }
            sc[i] = a;
        }
#undef KI_DMA
        const int cq = 4 * wid + (lane >> 4), pl = lane & 15;
        {
            LAS unsigned char* xw = ldsall + L2_XB + (2 * wid + h) * 2064 + c * 64; const int swz_w = (c >> 2) & 3;
            LAS unsigned char* xr = ldsall + L2_XB + pl * 2064 + cq * 64; const int swz_r = (cq >> 2) & 3;
            __syncthreads();
#pragma unroll
            for (int i = 0; i < 8; ++i) if (8 * i < nkb) {
#pragma unroll
                for (int q4 = 0; q4 < 4; ++q4) *(LAS f32x4*)(xw + (i & 1) * 33024 + 16 * (q4 ^ swz_w)) = (f32x4){sc[i][4 * q4], sc[i][4 * q4 + 1], sc[i][4 * q4 + 2], sc[i][4 * q4 + 3]};
                __syncthreads();
#pragma unroll
                for (int q4 = 0; q4 < 4; ++q4) { const f32x4 v = *(const LAS f32x4*)(xr + (i & 1) * 33024 + 16 * (q4 ^ swz_r)); sc[i][4 * q4] = v[0]; sc[i][4 * q4 + 1] = v[1]; sc[i][4 * q4 + 2] = v[2]; sc[i][4 * q4 + 3] = v[3]; }
            }
            __syncthreads();
        }
#define DPP_I(x, ctrl) __builtin_amdgcn_update_dpp(0, (x), (ctrl), 0xF, 0xF, true)
#define DPP_F(x, ctrl) __int_as_float(DPP_I(__float_as_int(x), (ctrl)))
        float mn = INFINITY, mx = -INFINITY;
#pragma unroll
        for (int i = 0; i < 8; ++i) if (8 * i < nkb) {
            const bool val = (pl >> 1) + 8 * i < nkb;
#pragma unroll
            for (int r = 0; r < 16; ++r) { mn = fminf(mn, val ? sc[i][r] : INFINITY); mx = fmaxf(mx, sc[i][r]); }
        }
        mn = fminf(mn, DPP_F(mn, 0xB1)); mn = fminf(mn, DPP_F(mn, 0x4E)); mn = fminf(mn, DPP_F(mn, 0x141)); mn = fminf(mn, DPP_F(mn, 0x140));
        mx = fmaxf(mx, DPP_F(mx, 0xB1)); mx = fmaxf(mx, DPP_F(mx, 0x4E)); mx = fmaxf(mx, DPP_F(mx, 0x141)); mx = fmaxf(mx, DPP_F(mx, 0x140));
        float lo = mn, hi = mx;
        bool done = false; float thr = lo; int tot0 = 0;
        LAS int* ztl = (LAS int*)(ldsall + L2_ZT) + wid * 64 + lane;
        int nval = 0;
#pragma unroll
        for (int i = 0; i < 8; ++i) nval += (8 * i < nkb) ? 16 : 0;
        for (int it = 0; it < 66; ++it) {
            const float mid = 0.5f * lo + 0.5f * hi;
            const bool degenerate = !(mid > lo && mid < hi);
            const float t = done ? thr : (it == 0 ? 1e-30f : (it == 1 ? 0.0f : mid));
            unsigned a0 = 0u, a1 = 0u, a2 = 0u, a3 = 0u; const f32x2_t tt = (f32x2_t){t, t};
#pragma unroll
            for (int i = 0; i < 8; ++i) if (8 * i < nkb) {
#pragma unroll
                for (int r = 0; r < 16; r += 4) {
                    const f32x2_t d01 = (f32x2_t){sc[i][r], sc[i][r + 1]} - tt, d23 = (f32x2_t){sc[i][r + 2], sc[i][r + 3]} - tt;
                    a0 = __builtin_amdgcn_alignbit(a0, __float_as_uint(d01.x), 31); a1 = __builtin_amdgcn_alignbit(a1, __float_as_uint(d01.y), 31);
                    a2 = __builtin_amdgcn_alignbit(a2, __float_as_uint(d23.x), 31); a3 = __builtin_amdgcn_alignbit(a3, __float_as_uint(d23.y), 31);
                }
            }
            int tot = nval - (__builtin_popcount(a0) + __builtin_popcount(a1) + __builtin_popcount(a2) + __builtin_popcount(a3));
            tot += DPP_I(tot, 0xB1); tot += DPP_I(tot, 0x4E); tot += DPP_I(tot, 0x141); tot += DPP_I(tot, 0x140);
#define ZERO_PROBES(c0, c1) do { *ztl = ((c0) > 256 && (c1) < 256) ? 256 - (c1) : -1; \
                if ((c0) >= 256 && (c1) < 256) { done = true; thr = 0.0f; } \
                else if ((c1) >= 256) { lo = fmaxf(lo, 1e-30f); if ((c1) == 256) { done = true; thr = 1e-30f; } } \
                else hi = fminf(hi, 0.0f); } while (0)
            if (it == 0) { tot0 = tot;
                if (!__any(tot < 256)) { ZERO_PROBES(tot, tot); it = 1; } }
            else if (it == 1) ZERO_PROBES(tot, tot0);
            else if (!done) {
                if (degenerate) { done = true; thr = lo; }
                else if (tot == 256) { done = true; thr = mid; }
                else if (tot > 256) lo = mid; else hi = mid;
            }
#undef ZERO_PROBES
            if (__all(done)) break;
        }
#undef DPP_I
#undef DPP_F
        if (!done) thr = lo;
        const int ztake = *ztl; const bool tie = ztake >= 0;
        const int hn = pl & 1;
#pragma unroll
        for (int i = 0; i < 8; ++i) if (8 * i < nkb) {
            u32x4 w = (u32x4){0u, 0u, 0u, 0u};
#pragma unroll
            for (int r = 0; r < 16; ++r) w[r >> 2] |= (sc[i][r] >= thr) ? 0u : (0xFEu << (8 * (r & 3)));
            *(LAS u32x4*)(m8 + ((pl + 16 * i) * 32 + cq) * 16) = w;
        }
        if (__any(tie)) {
            LAS unsigned short* zmask16 = (LAS unsigned short*)(ldsall + L2_ZM);
#pragma unroll
            for (int i = 0; i < 8; ++i) if (8 * i < nkb) {
                unsigned z = 0;
#pragma unroll
                for (int r = 0; r < 16; ++r) z |= (sc[i][r] == 0.0f) ? (1u << r) : 0u;
                zmask16[cq * 128 + pl + 16 * i] = (unsigned short)z;
            }
            asm volatile("s_waitcnt lgkmcnt(0)" ::: "memory");
            const LAS unsigned* zw = (const LAS unsigned*)(ldsall + L2_ZM);
            int prefix = 0, kdone = 0;
#pragma unroll 1
            for (int kb = pl >> 1; kb < nkb; kb += 8) {
#pragma unroll 1
                for (; kdone < kb; ++kdone) prefix += __builtin_popcount(zw[cq * 64 + kdone]);
                const unsigned w = zw[cq * 64 + kb], b0 = w & 0xffffu, b1 = w >> 16;
                unsigned W = 0;
#pragma unroll
                for (int g = 0; g < 4; ++g) W |= (((b0 >> (4 * g)) & 0xfu) << (8 * g)) | (((b1 >> (4 * g)) & 0xfu) << (8 * g + 4));
                const unsigned mine = hn ? b1 : b0; unsigned add = 0;
#pragma unroll
                for (int r = 0; r < 16; ++r) { const int rho = crow(r, hn); const int rank = prefix + __builtin_popcount(W & ((1u << rho) - 1u)); add |= (((mine >> r) & 1u) && rank >= ztake) ? (1u << r) : 0u; }
                if (tie) { LAS u32x4* mp_ = (LAS u32x4*)(m8 + ((kb * 2 + hn) * 32 + cq) * 16); u32x4 w2 = *mp_;
#pragma unroll
                    for (int r = 0; r < 16; ++r) w2[r >> 2] |= (0u - ((add >> r) & 1u)) & (0xFEu << (8 * (r & 3)));
                    *mp_ = w2; }
            }
        }
    }
    {
        const bf16_t* qp = QA + (size_t)tokq * 512 + wid * 64 + 8 * h;
        bf16x8 qr[4];
#pragma unroll
        for (int s = 0; s < 4; ++s) qr[s] = ldfrag(qp + 16 * s);
        asm volatile("" : "+v"(qr[0]), "+v"(qr[1]), "+v"(qr[2]), "+v"(qr[3]));
        f32x16 O[2]; O[0] = zero16(); O[1] = zero16(); float l = 0.f;
        const int vbase = ((lane >> 4) & 1) * 32 + (lane & 3) * 8 + (4 * h + ((lane & 15) >> 2)) * 64;
        const int lane2 = lane_id();
        const bf16_t* ksrc2 = KA + (size_t)b * 131072 + wid * 512 + lane2 * 8;
        const bf16_t* vsrc2 = VA + (size_t)(b * SEQ + 16 * (wid & 3) + (lane2 >> 2)) * 64 + (wid >> 2) * 32 + (lane2 & 3) * 8;
#define DSA_DMA(tt) do { LAS unsigned char* ns_ = KVSLOT(tt); dma16(ksrc2 + (size_t)(tt) * 4096, ns_ + wid * 1024); dma16(vsrc2 + (size_t)(tt) * 64 * 64, ns_ + 8192 + wid * 1024); } while (0)
        if (chunk >= 1) DSA_DMA(1);
        for (int t = 0; t <= chunk; ++t) {
            if (t + 1 <= chunk) asm volatile("s_waitcnt vmcnt(2)" ::: "memory"); else asm volatile("s_waitcnt vmcnt(0)" ::: "memory");
            __syncthreads();
            if (t + 2 <= chunk) DSA_DMA(t + 2);
            const LAS unsigned char* ks = KVSLOT(t) + (h * 1024 + c * 16); const LAS unsigned char* vs = KVSLOT(t) + 8192 + vbase;
            asm volatile("" : "+v"(ks), "+v"(vs));
            f32x16 S[2];
#pragma unroll
            for (int blk = 0; blk < 2; ++blk) {
                const u32x4 mw = *(const LAS u32x4*)(m8 + (((2 * t + blk) * 2 + h) * 32 + c) * 16);
                f32x16 a;
#pragma unroll
                for (int r = 0; r < 16; ++r) a[r] = __uint_as_float(mw[r >> 2] << (24 - 8 * (r & 3)));
#pragma unroll
                for (int s = 0; s < 4; ++s) a = MFMA32(ldsfrag(ks + 2048 * s + 512 * blk), qr[s], a);
#pragma unroll
                for (int r = 0; r < 16; ++r) { const float p = __builtin_amdgcn_exp2f(a[r]); l += p; a[r] = p; }
                S[blk] = a;
            }
#pragma unroll
            for (int s4 = 0; s4 < 4; ++s4) {
                const bf16x8 pf = pack8(S[s4 >> 1], 8 * (s4 & 1));
#pragma unroll
                for (int db = 0; db < 2; ++db) {
                    const s16x4 v0 = tr16(vs + db * 4096 + s4 * 1024), v1 = tr16(vs + db * 4096 + s4 * 1024 + 512);
                    const bf16x8 vf = (bf16x8){v0[0], v0[1], v0[2], v0[3], v1[0], v1[1], v1[2], v1[3]};
                    O[db] = MFMA32(vf, pf, O[db]);
                }
            }
        }
#undef DSA_DMA
#undef KVSLOT
        l += __shfl_xor(l, 32);
        const float inv = 1.0f / l;
        int hh = h; asm volatile("" : "+v"(hh));
        bf16_t* yrow = Y + (size_t)tokq * DM + wid * 64;
        u32x2 w[8];
#pragma unroll
        for (int db = 0; db < 2; ++db)
#pragma unroll
            for (int rg = 0; rg < 4; ++rg) { w[4 * db + rg].x = cvt_pk_bf16(O[db][4 * rg] * inv, O[db][4 * rg + 1] * inv); w[4 * db + rg].y = cvt_pk_bf16(O[db][4 * rg + 2] * inv, O[db][4 * rg + 3] * inv); }
        unsigned char* yb = (unsigned char*)yrow + 16 * hh;
#pragma unroll
        for (int k = 0; k < 8; k += 2) {
            const auto rx = __builtin_amdgcn_permlane32_swap(w[k].x, w[k + 1].x, false, false), ry = __builtin_amdgcn_permlane32_swap(w[k].y, w[k + 1].y, false, false);
            *(u32x4*)(yb + 16 * k) = (u32x4){(unsigned)rx[0], (unsigned)ry[0], (unsigned)rx[1], (unsigned)ry[1]};
        }
    }
}

__device__ __forceinline__ void diff_unit(const Ctx& X, const Params& P, LAS unsigned char* ldsall, int b, int hb, int qt16, float lam) {
    unsigned char* ws = P.ws;
    const bf16_t* QB = (const bf16_t*)(ws + WS_QB); const bf16_t* KB = (const bf16_t*)(ws + WS_KB); const bf16_t* VB = (const bf16_t*)(ws + WS_VBT);
    bf16_t* Y = (bf16_t*)(ws + WS_H);
    const float* gsub = CF(ws, C_GSUB);
    const int wid = X.wid, lane = lane_id(), c = lane & 31, h = lane >> 5, qg = wid & 3, mp = wid >> 2;
    const int q0 = qt16 * 128 + 32 * qg, chunk = q0 >> 6, ntile = 2 * qt16 + 2;
    const int tokq = b * SEQ + q0 + c;
    LAS unsigned char* ring = ldsall + L2_DIFF;
    bf16x8 qf[4];
    { const bf16_t* qp = QB + (size_t)tokq * 512 + hb * 128 + mp * 64 + 8 * h;
#pragma unroll
      for (int s = 0; s < 4; ++s) qf[s] = ldfrag(qp + 16 * s); }
    asm volatile("" : "+v"(qf[0]), "+v"(qf[1]), "+v"(qf[2]), "+v"(qf[3]));
    const bf16_t* k1src = KB + (size_t)((b * 4 + hb) * 2) * 131072 + wid * 512 + lane * 8;
    const bf16_t* vsrc0 = VB + (size_t)(b * SEQ + 16 * (wid & 3) + (lane >> 2)) * 512 + hb * 128 + (wid >> 2) * 32 + (lane & 3) * 8;
    __syncthreads();
#define DIFF_DMA(tt) do { LAS unsigned char* ns_ = ring + ((tt) % 3) * 32768; const bf16_t* kn_ = k1src + (size_t)(tt) * 4096; const bf16_t* vn_ = vsrc0 + (size_t)(tt) * 64 * 512; \
        dma16(kn_, ns_ + wid * 1024); dma16(kn_ + 131072, ns_ + 8192 + wid * 1024); dma16(vn_, ns_ + 16384 + wid * 1024); dma16(vn_ + 64, ns_ + 16384 + (wid + 8) * 1024); } while (0)
    DIFF_DMA(0); if (ntile > 1) DIFF_DMA(1);
    f32x16 O[4];
#pragma unroll
    for (int db = 0; db < 4; ++db) O[db] = zero16();
    float l = 0.f;
    const int vbase = ((lane >> 4) & 1) * 32 + (lane & 3) * 8 + (4 * h + ((lane & 15) >> 2)) * 64;
    for (int t = 0; t < ntile; ++t) {
        if (t + 1 < ntile) asm volatile("s_waitcnt vmcnt(4)" ::: "memory"); else asm volatile("s_waitcnt vmcnt(0)" ::: "memory");
        __syncthreads();
        if (t + 2 < ntile) DIFF_DMA(t + 2);
        if (t <= chunk) {
            const LAS unsigned char* ks = ring + (t % 3) * 32768 + mp * 8192 + (h * 1024 + c * 16); const LAS unsigned char* vs = ring + (t % 3) * 32768 + 16384 + vbase;
            asm volatile("" : "+v"(ks), "+v"(vs));
#define DIFF_LOADV(dst, s4_) do { _Pragma("unroll") for (int db = 0; db < 4; ++db) { const s16x4 v0 = tr16(vs + db * 4096 + (s4_) * 1024), v1 = tr16(vs + db * 4096 + (s4_) * 1024 + 512); \
                dst[db] = (bf16x8){v0[0], v0[1], v0[2], v0[3], v1[0], v1[1], v1[2], v1[3]}; } } while (0)
#define DIFF_PV4(src, pf_) do { _Pragma("unroll") for (int db = 0; db < 4; ++db) O[db] = MFMA32(src[db], pf_, O[db]); } while (0)
            f32x16 A[2];
            bf16x8 kf[8], va[4], vb[4];
#pragma unroll
            for (int i = 0; i < 8; ++i) kf[i] = ldsfrag(ks + 2048 * (i & 3) + 512 * (i >> 2));
#pragma unroll
            for (int blk = 0; blk < 2; ++blk) {
                f32x16 s1 = zero16();
#pragma unroll
                for (int s = 0; s < 4; ++s) s1 = MFMA32(kf[4 * blk + s], qf[s], s1);
                A[blk] = s1;
            }
            DIFF_LOADV(va, 0); DIFF_LOADV(vb, 1);
            __builtin_amdgcn_sched_barrier(0);
#pragma unroll
            for (int blk = 0; blk < 2; ++blk)
#pragma unroll
                for (int r = 0; r < 16; ++r) { A[blk][r] = __builtin_amdgcn_exp2f(A[blk][r]); l += A[blk][r]; }
            bf16x8 pf[4];
#pragma unroll
            for (int s4 = 0; s4 < 4; ++s4) pf[s4] = pack8(A[s4 >> 1], 8 * (s4 & 1));
            __builtin_amdgcn_sched_barrier(0);
            DIFF_PV4(va, pf[0]); DIFF_LOADV(va, 2);
            __builtin_amdgcn_sched_barrier(0);
            DIFF_PV4(vb, pf[1]); DIFF_LOADV(vb, 3);
            __builtin_amdgcn_sched_barrier(0);
            DIFF_PV4(va, pf[2]); DIFF_PV4(vb, pf[3]);
#undef DIFF_LOADV
#undef DIFF_PV4
        }
    }
#undef DIFF_DMA
    l += __shfl_xor(l, 32);
    __syncthreads();
    LAS float* comb = (LAS float*)ring + qg * 4096;
    if (mp == 1) {
        const float sc = lam / l;
#pragma unroll
        for (int db = 0; db < 4; ++db)
#pragma unroll
            for (int r = 0; r < 16; ++r) comb[(db * 16 + r) * 64 + lane] = O[db][r] * sc;
    }
    __syncthreads();
    if (mp == 0) {
        const float inv = 1.0f / l;
        float ss = 0.f;
#pragma unroll
        for (int db = 0; db < 4; ++db)
#pragma unroll
            for (int r = 0; r < 16; ++r) { const float o = O[db][r] * inv - comb[(db * 16 + r) * 64 + lane]; O[db][r] = o; ss += o * o; }
        ss += __shfl_xor(ss, 32);
        const float rinv = (1.0f - LAM_INIT) / sqrtf(ss * (1.0f / 128.0f) + NORM_EPS);
        int hh = h; asm volatile("" : "+v"(hh));
        bf16_t* yrow = Y + (size_t)tokq * DM + 512 + hb * 128;
        unsigned char* yb = (unsigned char*)yrow + 16 * hh;
#pragma unroll
        for (int db = 0; db < 4; ++db)
#pragma unroll
            for (int rp = 0; rp < 4; rp += 2) {
                u32x2 w[2];
#pragma unroll
                for (int q = 0; q < 2; ++q) { const int rg = rp + q, d = 32 * db + 8 * rg + 4 * hh;
                    const f32x4 gv = *(const f32x4*)(gsub + d);
                    w[q].x = cvt_pk_bf16(O[db][4 * rg] * rinv * gv[0], O[db][4 * rg + 1] * rinv * gv[1]); w[q].y = cvt_pk_bf16(O[db][4 * rg + 2] * rinv * gv[2], O[db][4 * rg + 3] * rinv * gv[3]); }
                const auto rx = __builtin_amdgcn_permlane32_swap(w[0].x, w[1].x, false, false), ry = __builtin_amdgcn_permlane32_swap(w[0].y, w[1].y, false, false);
                *(u32x4*)(yb + 16 * (4 * db + rp)) = (u32x4){(unsigned)rx[0], (unsigned)ry[0], (unsigned)rx[1], (unsigned)ry[1]};
            }
    }
}

__device__ __forceinline__ void p2_mixers(const Ctx& X, const Params& P, LAS unsigned char* ldsall) {
    const bool xl = (X.nwg & 7) == 0; const int gx = X.nwg >> 3;
    for (int i = 0;; ++i) {
        int u; if (xl) { const int v = X.mk + gx * i; if (v >= 128) break; u = X.mx * 128 + v; } else { u = X.wg + X.nwg * i; if (u >= NBATCH * 32) break; }
        const int b = u >> 5, j = ((u & 31) + (((X.nwg & 31) == 0) ? 8 * i : 0)) & 31;
        dsa_unit(X, P, ldsall, b, j);
        dsa_unit(X, P, ldsall, b, 63 - j);
    }
    float lam;
    { const float a = wave_sum(CF(P.ws, C_LQ1)[X.lane] * CF(P.ws, C_LK1)[X.lane]), bq = wave_sum(CF(P.ws, C_LQ2)[X.lane] * CF(P.ws, C_LK2)[X.lane]); lam = expf(a) - expf(bq) + LAM_INIT; }
    for (int i = 0;; ++i) {
        int u; if (xl) { const int v = X.mk + gx * i; if (v >= 128) break; u = X.mx * 128 + v; } else { u = X.wg + X.nwg * i; if (u >= NBATCH * 4 * 8) break; }
        const int j = u & 7, hb = (u >> 3) & 3, b = u >> 5;
        diff_unit(X, P, ldsall, b, hb, j, lam);
        diff_unit(X, P, ldsall, b, hb, 15 - j, lam);
    }
}

namespace g8 {
typedef float f32x4 __attribute__((ext_vector_type(4)));
constexpr int BM = 256, BK = 64, HALF = 128, HTB = HALF * BK * 2, STAGE_BYTES = 8 * HTB, KDIM = 1024, NT = KDIM / BK;
__device__ __forceinline__ int lds_byte(int r, int c) { const int st = (r >> 4) * 2 + (c >> 5), rr = r & 15, cc = c & 31, ob = rr * 64 + cc * 2; return st * 1024 + (ob ^ (((ob >> 9) & 1) << 5)); }
__device__ __forceinline__ void stage_rc(int b, int& R, int& C) { const int st = b / 1024, sb = b % 1024, swz = sb ^ (((sb >> 9) & 1) << 5); R = (st >> 1) * 16 + swz / 64; C = (st & 1) * 32 + (swz % 64) / 2; }
__device__ __forceinline__ int perm32(int rho) { const int n = rho >> 4, i = rho & 15; return 8 * (i >> 2) + 4 * n + (i & 3); }

struct Unit { int rt, pn, e, row0, nvalid; };

template <class Epi, class Sched, bool GATHER, bool F8 = false>
__device__ __forceinline__ void gemm_phase(LAS unsigned char* lds, LAS unsigned char* ldsidx, const Sched& S, const Epi& E, int wid_) {
    int lane = lane_id(); asm volatile("" : "+v"(lane));
    const int wid = wid_, tid = wid * 64 + lane, wr = wid >> 2, wc = wid & 3, fr = lane & 15, fq = lane >> 4;
    constexpr int RP = F8 ? 1024 : 2048, nt = RP / 128;
    unsigned voffB[2], cu[2][2];
#pragma unroll
    for (int i = 0; i < 2; ++i) { int R, C; stage_rc(tid * 16 + i * 8192, R, C); const int Rb = Epi::PERM ? ((R & ~31) + perm32(R & 31)) : R;
        voffB[i] = (unsigned)(Rb * RP + C * 2);
        cu[0][i] = (unsigned)(R * RP + C * 2); cu[1][i] = (unsigned)((R + HALF) * RP + C * 2); }
    const size_t kstep = (size_t)(BK * 2);
    const size_t hstep = (size_t)HALF * RP;
    const unsigned lbase = (unsigned)__builtin_amdgcn_readfirstlane((int)((unsigned)(uintptr_t)lds + (unsigned)wid * 1024u));
    const int aoff = F8 ? lds_byte(wr * 64 + fr, fq * 16) : lds_byte(wr * 64 + fr, fq * 8), boff = F8 ? lds_byte(wc * 32 + fr, fq * 16) : lds_byte(wc * 32 + fr, fq * 8);
    constexpr int KOFF = F8 ? 16 : 1024;
#define G8_SA(b, h) (((b) * 2 + (h)) * HTB)
#define G8_SB(b, h) ((4 + (b) * 2 + (h)) * HTB)
#define G8_DMA(gbase, voff, ldsoff) do { unsigned sv_; \
        asm volatile("s_mov_b32 %0, m0\n\ts_add_u32 m0, %3, %4\n\ts_nop 0\n\tglobal_load_lds_dwordx4 %1, %2\n\ts_mov_b32 m0, %0" : "=&s"(sv_) : "v"(voff), "s"(gbase), "s"(lbase), "n"(ldsoff) : "memory", "scc"); } while (0)
#define G8_STAGEB(bufoff, gbase) do { G8_DMA((gbase), voffB[0], (bufoff)); G8_DMA((gbase), voffB[1], (bufoff) + 8192); } while (0)
#define G8_STAGEA_(bufoff, gbase, o0, o1) do { G8_DMA((gbase), (o0), (bufoff)); G8_DMA((gbase), (o1), (bufoff) + 8192); } while (0)
#define G8_STAGEA(bufoff, gbase, hh) do { if constexpr (GATHER) { G8_STAGEA_(bufoff, gbase, cu[hh][0], cu[hh][1]); } else { G8_STAGEA_(bufoff, (gbase) + (hh) * hstep, cu[0][0], cu[0][1]); } } while (0)
#define G8_LDA(dst, b, h) do { _Pragma("unroll") for (int m = 0; m < 4; ++m) _Pragma("unroll") for (int k = 0; k < 2; ++k) dst[m][k] = *(const LAS bf16x8*)(lds + G8_SA(b, h) + aoff + m * 2048 + k * KOFF); } while (0)
#define G8_LDB(dst, b, h) do { _Pragma("unroll") for (int n = 0; n < 2; ++n) _Pragma("unroll") for (int k = 0; k < 2; ++k) dst[n][k] = *(const LAS bf16x8*)(lds + G8_SB(b, h) + boff + n * 2048 + k * KOFF); } while (0)
#define G8_MMA(ai, bj, At, Bt) do { __builtin_amdgcn_s_setprio(1); \
        if constexpr (F8) { _Pragma("unroll") for (int m = 0; m < 4; ++m) _Pragma("unroll") for (int n = 0; n < 2; ++n) { \
            const u32x4 b0_ = __builtin_bit_cast(u32x4, Bt[n][0]), b1_ = __builtin_bit_cast(u32x4, Bt[n][1]), a0_ = __builtin_bit_cast(u32x4, At[m][0]), a1_ = __builtin_bit_cast(u32x4, At[m][1]); \
            const v8i32 bw_ = (v8i32){(int)b0_.x, (int)b0_.y, (int)b0_.z, (int)b0_.w, (int)b1_.x, (int)b1_.y, (int)b1_.z, (int)b1_.w}, aw_ = (v8i32){(int)a0_.x, (int)a0_.y, (int)a0_.z, (int)a0_.w, (int)a1_.x, (int)a1_.y, (int)a1_.z, (int)a1_.w}; \
            acc[ai][bj][m][n] = __builtin_amdgcn_mfma_scale_f32_16x16x128_f8f6f4(bw_, aw_, acc[ai][bj][m][n], 0, 0, 0, W8_E8M0, 0, ONE_E8M0); } } \
        else { _Pragma("unroll") for (int m = 0; m < 4; ++m) _Pragma("unroll") for (int n = 0; n < 2; ++n) _Pragma("unroll") for (int k = 0; k < 2; ++k) \
            acc[ai][bj][m][n] = __builtin_amdgcn_mfma_f32_16x16x32_bf16(Bt[n][k], At[m][k], acc[ai][bj][m][n], 0, 0, 0); } \
        __builtin_amdgcn_s_setprio(0); } while (0)
#define G8_WAIT_V(n) asm volatile("s_waitcnt vmcnt(" #n ")" ::: "memory")
#define G8_WAIT_L(n) asm volatile("s_waitcnt lgkmcnt(" #n ")" ::: "memory")
#define G8_BAR __builtin_amdgcn_s_barrier()
#define G8_SCHED __builtin_amdgcn_sched_barrier(0)
    Unit cur, nxt; int ui = 0;
    if (!S.next(0, cur)) return;
    f32x4 acc[2][2][4][2];
    {
        f32x4 nb0[2][2];
        if constexpr (Epi::BIAS) { int t3_ = lane_id(); asm volatile("" : "+v"(t3_)); E.bias(cur, wc, t3_ >> 4, nb0); }
#pragma unroll
        for (int a = 0; a < 2; ++a)
#pragma unroll
            for (int b = 0; b < 2; ++b)
#pragma unroll
                for (int m = 0; m < 4; ++m)
#pragma unroll
                    for (int n = 0; n < 2; ++n) { if constexpr (Epi::BIAS) acc[a][b][m][n] = nb0[b][n]; else acc[a][b][m][n] = (f32x4){0.f, 0.f, 0.f, 0.f}; }
    }
    bf16x8 At[4][2], B0[2][2], B1[2][2];
    const char* cA = S.a_ptr(cur); const char* cB = S.b_ptr(cur);
    if constexpr (GATHER) {
        if (wid < 4) __builtin_amdgcn_global_load_lds((const unsigned*)(S.idx_ptr(cur) + wid * 64 + lane), (LAS unsigned*)(ldsidx + wid * 256), 4, 0, 0);
        G8_WAIT_V(0); G8_BAR;
        const LAS int* ix = (const LAS int*)ldsidx;
#pragma unroll
        for (int i = 0; i < 2; ++i) { int R, C; stage_rc(tid * 16 + i * 8192, R, C); cu[0][i] = (unsigned)(ix[R] * RP + C * 2); cu[1][i] = (unsigned)(ix[HALF + R] * RP + C * 2); }
        G8_WAIT_L(0); G8_BAR;
    }
    G8_STAGEB(G8_SB(0, 0), cB); G8_STAGEB(G8_SB(0, 1), cB + hstep); G8_STAGEA(G8_SA(0, 0), cA, 0); G8_STAGEA(G8_SA(0, 1), cA, 1);
    if (wr == 1) G8_BAR;
    G8_WAIT_V(2); G8_BAR;
    G8_STAGEB(G8_SB(1, 0), cB + kstep); G8_STAGEA(G8_SA(1, 0), cA + kstep, 0); G8_STAGEB(G8_SB(1, 1), cB + hstep + kstep);
    G8_WAIT_V(6); G8_BAR;
    for (;;) {
        const bool has_next = S.next(ui + 1, nxt);
        const char* nA = has_next ? S.a_ptr(nxt) : cA; const char* nB = has_next ? S.b_ptr(nxt) : cB;
        if constexpr (GATHER) {
            if (has_next && wid < 4) __builtin_amdgcn_global_load_lds((const unsigned*)(S.idx_ptr(nxt) + wid * 64 + lane), (LAS unsigned*)(ldsidx + ((ui + 1) & 1) * 1024 + wid * 256), 4, 0, 0);
        }
#pragma unroll 1
        for (int t = 0; t < nt; t += 2) {
            const bool last = (t == nt - 2);
            if constexpr (Epi::PREFETCH) { if (t == 2) E.prefetch(cur, lds + 131072, wid); }
            const char* a1 = cA + (size_t)(t + 1) * kstep;
            const char* a2 = last ? nA : cA + (size_t)(t + 2) * kstep; const char* b2 = last ? nB : cB + (size_t)(t + 2) * kstep;
            const char* a3 = a2 + kstep; const char* b3 = b2 + kstep;
            G8_LDB(B0, 0, 0); G8_LDB(B1, 0, 1); G8_SCHED; G8_LDA(At, 0, 0); G8_STAGEA(G8_SA(1, 1), a1, 1);
            G8_WAIT_V(8); G8_WAIT_L(0); G8_BAR; G8_MMA(0, 0, At, B0); G8_MMA(0, 1, At, B1); G8_BAR; G8_SCHED;
            if constexpr (GATHER) {
                if (last && has_next) { const LAS int* ix = (const LAS int*)(ldsidx + ((ui + 1) & 1) * 1024);
#pragma unroll
                    for (int i = 0; i < 2; ++i) { int R, C; stage_rc(tid * 16 + i * 8192, R, C); cu[0][i] = (unsigned)(ix[R] * RP + C * 2); cu[1][i] = (unsigned)(ix[HALF + R] * RP + C * 2); } }
            }
            G8_LDA(At, 0, 1); G8_STAGEB(G8_SB(0, 0), b2); G8_STAGEB(G8_SB(0, 1), b2 + hstep); G8_STAGEA(G8_SA(0, 0), a2, 0);
            G8_WAIT_V(8); G8_WAIT_L(0); G8_BAR; G8_MMA(1, 0, At, B0); G8_MMA(1, 1, At, B1); G8_BAR; G8_SCHED;
            G8_LDB(B0, 1, 0); G8_LDB(B1, 1, 1); G8_SCHED; G8_LDA(At, 1, 0); G8_STAGEA(G8_SA(0, 1), a2, 1);
            G8_WAIT_V(8); G8_WAIT_L(0); G8_BAR; G8_MMA(0, 0, At, B0); G8_MMA(0, 1, At, B1); G8_BAR; G8_SCHED;
            G8_LDA(At, 1, 1); G8_STAGEB(G8_SB(1, 0), b3); G8_STAGEB(G8_SB(1, 1), b3 + hstep); G8_STAGEA(G8_SA(1, 0), a3, 0);
            G8_WAIT_V(8); G8_WAIT_L(0); G8_BAR; G8_MMA(1, 0, At, B0); G8_MMA(1, 1, At, B1); G8_BAR; G8_SCHED;
        }
        if (wr == 0) G8_BAR;
        f32x4 nb[2][2];
        { int t2_ = lane_id(); asm volatile("" : "+v"(t2_));
          if constexpr (Epi::BIAS) E.bias(has_next ? nxt : cur, wc, t2_ >> 4, nb);
          E(acc, cur, wr, wc, t2_ & 15, t2_ >> 4); }
        if (!has_next) break;
#pragma unroll
        for (int a = 0; a < 2; ++a)
#pragma unroll
            for (int b = 0; b < 2; ++b)
#pragma unroll
                for (int m = 0; m < 4; ++m)
#pragma unroll
                    for (int n = 0; n < 2; ++n) { if constexpr (Epi::BIAS) acc[a][b][m][n] = nb[b][n]; else acc[a][b][m][n] = (f32x4){0.f, 0.f, 0.f, 0.f}; }
        cur = nxt; cA = nA; cB = nB; ++ui;
        if (wr == 1) G8_BAR;
    }
    G8_WAIT_V(0);
    G8_BAR;
#undef G8_SA
#undef G8_SB
#undef G8_STAGEA
#undef G8_STAGEA_
#undef G8_DMA
#undef G8_STAGEB
#undef G8_LDA
#undef G8_LDB
#undef G8_MMA
#undef G8_WAIT_V
#undef G8_WAIT_L
#undef G8_BAR
#undef G8_SCHED
}

struct DenseSched {
    const char* A; const char* B; int t0, t1, npn, x, k, gx;
    __device__ __forceinline__ bool next(int i, Unit& u) const {
        const int j = i * gx + k, q = j / npn, rt = t0 + x + 8 * q;
        if (rt >= t1) return false;
        u.rt = rt; u.pn = j - q * npn; u.e = 0; u.row0 = rt * BM; u.nvalid = BM;
        return true;
    }
    __device__ __forceinline__ const char* a_ptr(const Unit& u) const { return A + (size_t)u.rt * (BM * KDIM * 2); }
    __device__ __forceinline__ const char* b_ptr(const Unit& u) const { return B + (size_t)u.pn * (BM * KDIM * 2); }
    __device__ __forceinline__ const int* idx_ptr(const Unit&) const { return nullptr; }
};
}


struct EpiInProj {
    static constexpr bool PERM = true, PREFETCH = true, BIAS = false;
    unsigned char* ws; LAS unsigned char* xr;
    __device__ __forceinline__ void prefetch(const g8::Unit& u, LAS unsigned char* xbuf, int wid) const {
        const int lane = lane_id();
        const unsigned char* src = ws + WS_ROPE + (size_t)u.rt * (256 * 64);
#pragma unroll
        for (int i = 0; i < 2; ++i) { const int pc = wid + 8 * i, P = pc * 64 + lane, row = P >> 2, uu = P & 3;
            dma16(src + (size_t)(row * 4 + (uu ^ ((row >> 2) & 3))) * 16, xbuf + pc * 1024); }
    }
    template <bool GAIN, bool ROPE, int KMODE>
    __device__ __forceinline__ void body(const g8::f32x4 (&acc)[2][2][4][2], const g8::Unit& u, int wr, int fr, int fq, const float* gain, float scale, bf16_t* dst, int pitch) const {
        g8::f32x4 gv[2][2];
        if constexpr (GAIN) {
#pragma unroll
            for (int bj = 0; bj < 2; ++bj)
#pragma unroll
                for (int n = 0; n < 2; ++n) gv[bj][n] = *(const g8::f32x4*)(gain + 32 * bj + 8 * fq + 4 * n) * scale;
        }
#pragma unroll
        for (int ai = 0; ai < 2; ++ai)
#pragma unroll
            for (int m = 0; m < 4; ++m) {
                const int tok = 256 * u.rt + 128 * ai + 64 * wr + 16 * m + fr;
                g8::f32x4 y[2][2];
                if constexpr (GAIN) {
                    float ss = 0.f;
#pragma unroll
                    for (int bj = 0; bj < 2; ++bj)
#pragma unroll
                        for (int n = 0; n < 2; ++n) { const g8::f32x4 v = acc[ai][bj][m][n]; ss += (v[0] * v[0] + v[1] * v[1]) + (v[2] * v[2] + v[3] * v[3]); }
                    { const auto r_ = __builtin_amdgcn_permlane16_swap(__float_as_uint(ss), __float_as_uint(ss), false, false); ss = __uint_as_float(r_[0]) + __uint_as_float(r_[1]); }
                    { const auto r_ = __builtin_amdgcn_permlane32_swap(__float_as_uint(ss), __float_as_uint(ss), false, false); ss = __uint_as_float(r_[0]) + __uint_as_float(r_[1]); }
                    const float rinv = __builtin_amdgcn_rsqf(ss * (1.0f / 64.0f) + NORM_EPS);
#pragma unroll
                    for (int bj = 0; bj < 2; ++bj)
#pragma unroll
                        for (int n = 0; n < 2; ++n) y[bj][n] = acc[ai][bj][m][n] * rinv * gv[bj][n];
                } else {
#pragma unroll
                    for (int bj = 0; bj < 2; ++bj)
#pragma unroll
                        for (int n = 0; n < 2; ++n) y[bj][n] = acc[ai][bj][m][n];
                }
                if constexpr (ROPE) {
                    const int rowu = 128 * ai + 64 * wr + 16 * m + fr;
                    const LAS unsigned char* rbase = (fq < 2) ? xr + rowu * 64 : xr + 16384; const int sw = (fq < 2) ? (rowu >> 2) & 3 : 0;
                    const int uA = (fq & 1) ? 2 : 0, uB = 2 - uA; const unsigned sgnB = (fq == 0) ? 0x80000000u : 0u;
#pragma unroll
                    for (int n = 0; n < 2; ++n) {
                        const g8::f32x4 A4 = *(const LAS g8::f32x4*)(rbase + 16 * ((uA + n) ^ sw)), B4 = *(const LAS g8::f32x4*)(rbase + 16 * ((uB + n) ^ sw));
#pragma unroll
                        for (int e = 0; e < 4; ++e) {
                            const unsigned xm = __float_as_uint(y[0][n][e]);
                            const auto r_ = __builtin_amdgcn_permlane16_swap(xm, xm, false, false);
                            const float lo_ = __uint_as_float(r_[0]), hi_ = __uint_as_float(r_[1]), bs_ = __uint_as_float(__float_as_uint(B4[e]) ^ sgnB);
                            float t_;
                            asm("v_mul_f32 %0, %1, %2" : "=v"(t_) : "v"(hi_), "v"(bs_));
                            asm("v_fmac_f32 %0, %1, %2" : "+v"(t_) : "v"(lo_), "v"(A4[e]));
                            y[0][n][e] = t_;
                        }
                    }
                }
                const int bb = tok >> 11, ss_ = tok & 2047;
                bf16_t* drow; int bjstep;
                if constexpr (KMODE == 0) { drow = dst + (size_t)tok * pitch + 8 * fq; bjstep = 32; }
                else if constexpr (KMODE == 1) { drow = dst + (size_t)bb * 1048576 + (ss_ >> 6) * 4096 + fq * 512 + (ss_ & 63) * 8; bjstep = 2048; }
                else if constexpr (KMODE == 2) { drow = dst + (size_t)bb * 131072 + (ss_ >> 6) * 4096 + fq * 512 + (ss_ & 63) * 8; bjstep = 2048; }
                else { drow = dst + (size_t)bb * 131072 + (ss_ >> 5) * 2048 + fq * 256 + (ss_ & 31) * 8; bjstep = 1024; }
#pragma unroll
                for (int bj = 0; bj < 2; ++bj) {
                    u32x4 w; w.x = cvt_pk_bf16(y[bj][0][0], y[bj][0][1]); w.y = cvt_pk_bf16(y[bj][0][2], y[bj][0][3]);
                    w.z = cvt_pk_bf16(y[bj][1][0], y[bj][1][1]); w.w = cvt_pk_bf16(y[bj][1][2], y[bj][1][3]);
                    *(u32x4*)(drow + bjstep * bj) = w;
                }
                asm volatile("" ::: "memory");
            }
    }
    __device__ __forceinline__ void operator()(const g8::f32x4 (&acc)[2][2][4][2], const g8::Unit& u, int wr, int wc, int fr, int fq) const {
        asm volatile("" : "+v"(fr), "+v"(fq));
        const int g = 4 * u.pn + wc;
        if (g < 8) body<true, true, 0>(acc, u, wr, fr, fq, CF(ws, C_GQA), QSCALE, (bf16_t*)(ws + WS_QA) + g * 64, 512);
        else if (g < 16) body<false, true, 0>(acc, u, wr, fr, fq, nullptr, 1.0f, (bf16_t*)(ws + WS_QI) + (g - 8) * 64, 512);
        else if (g < 24) body<true, true, 0>(acc, u, wr, fr, fq, CF(ws, C_GQB), QSCALE, (bf16_t*)(ws + WS_QB) + (g - 16) * 64, 512);
        else if (g < 32) body<true, true, 1>(acc, u, wr, fr, fq, CF(ws, C_GKB), 1.0f, (bf16_t*)(ws + WS_KB) + (size_t)(g - 24) * 131072, 0);
        else if (g < 40) body<false, false, 0>(acc, u, wr, fr, fq, nullptr, 1.0f, (bf16_t*)(ws + WS_VBT) + (g - 32) * 64, 512);
        else if (g == 40) body<true, true, 2>(acc, u, wr, fr, fq, CF(ws, C_GKA), 1.0f, (bf16_t*)(ws + WS_KA), 0);
        else if (g == 41) body<false, false, 0>(acc, u, wr, fr, fq, nullptr, 1.0f, (bf16_t*)(ws + WS_VAT), 64);
        else if (g == 42) body<true, true, 3>(acc, u, wr, fr, fq, CF(ws, C_GIK), 1.0f, (bf16_t*)(ws + WS_KI), 0);
        else {
#pragma unroll
            for (int ai = 0; ai < 2; ++ai)
#pragma unroll
                for (int m = 0; m < 4; ++m) {
                    const int tok = 256 * u.rt + 128 * ai + 64 * wr + 16 * m + fr;
                    if (fq == 0) { float* wi = (float*)(ws + WS_WI) + (size_t)tok * 8; *(g8::f32x4*)wi = acc[ai][0][m][0] * IW_SCALE; *(g8::f32x4*)(wi + 4) = acc[ai][0][m][1] * IW_SCALE; }
                }
        }
    }
};
__device__ __forceinline__ void p1_inproj_g8(const Ctx& X, const Params& P, LAS unsigned char* ldsall) {
    g8::DenseSched S; S.A = (const char*)(P.ws + WS_H); S.B = (const char*)(P.ws + WS_WIN); S.t0 = 0; S.t1 = T_TOK / 256; S.npn = NGROUP / 4; S.x = X.mx; S.k = X.mk; S.gx = X.nwg >> 3;
    if (X.tid < 16) ((LAS float*)(ldsall + 4096 + 131072 + 16384))[X.tid] = X.tid < 8 ? 1.0f : 0.0f;
    __syncthreads();
    EpiInProj E{P.ws, ldsall + 4096 + 131072};
    g8::gemm_phase<EpiInProj, g8::DenseSched, false>(ldsall + 4096, ldsall + 2048, S, E, X.wid);
}

struct EpiOutProj {
    static constexpr bool PERM = true, PREFETCH = false, BIAS = false;
    const float* x; bf16_t* x1b;
    __device__ __forceinline__ void operator()(const g8::f32x4 (&acc)[2][2][4][2], const g8::Unit& u, int wr, int wc, int fr, int fq) const {
        asm volatile("" : "+v"(fr), "+v"(fq));
        const int row0 = u.rt * 256 + wr * 64 + fr, col0 = u.pn * 256 + wc * 32 + 8 * fq;
#pragma unroll
        for (int ai = 0; ai < 2; ++ai)
#pragma unroll
            for (int m = 0; m < 4; ++m) {
                const size_t ro = (size_t)(row0 + ai * 128 + m * 16) * DM + col0;
#pragma unroll
                for (int bj = 0; bj < 2; ++bj) {
                    const g8::f32x4 v0 = *(const g8::f32x4*)(x + ro + bj * 128) + acc[ai][bj][m][0], v1 = *(const g8::f32x4*)(x + ro + bj * 128 + 4) + acc[ai][bj][m][1];
                    u32x4 w; w.x = cvt_pk_bf16(v0[0], v0[1]); w.y = cvt_pk_bf16(v0[2], v0[3]); w.z = cvt_pk_bf16(v1[0], v1[1]); w.w = cvt_pk_bf16(v1[2], v1[3]);
                    *(u32x4*)(x1b + ro + bj * 128) = w;
                }
            }
    }
};
__device__ __forceinline__ void p3_outproj_g8(const Ctx& X, const Params& P, LAS unsigned char* ldsall) {
    g8::DenseSched S; S.A = (const char*)(P.ws + WS_H); S.B = (const char*)(P.ws + WS_WO); S.t0 = 0; S.t1 = T_TOK / 256; S.npn = 4; S.x = X.mx; S.k = X.mk; S.gx = X.nwg >> 3;
    EpiOutProj E{P.in[0], (bf16_t*)(P.ws + WS_X1B)};
    g8::gemm_phase<EpiOutProj, g8::DenseSched, false>(ldsall + 4096, ldsall + 2048, S, E, X.wid);
}

__device__ __forceinline__ void p4_router(const Ctx& X, const Params& P) {
    unsigned char* ws = P.ws;
    const bf16_t* x1b = (const bf16_t*)(ws + WS_X1B); const float* g = CF(ws, C_GFFN);
    const bf16_t* WR = (const bf16_t*)(ws + WS_WR);
    const float* brt = CF(ws, C_BRT);
    int* topk_e = (int*)(ws + WS_TOPK_E); float* topk_g = (float*)(ws + WS_TOPK_G); int* CNT = (int*)(ws + WS_CNT);
    const int c = X.c, h = X.h, lane = X.lane;
    LAS int* hist = (LAS int*)X.lds;
    for (int wgt = X.wg; wgt < T_TOK / 256; wgt += X.nwg) {
        if (X.tid < 32) hist[X.tid] = 0;
        __syncthreads();
        const int tok0 = wgt * 256 + X.wid * 32;
        f32x4 gv4[4];
#pragma unroll
        for (int i = 0; i < 2; ++i) { gv4[2 * i] = ((const f32x4*)g)[2 * (lane + 64 * i)]; gv4[2 * i + 1] = ((const f32x4*)g)[2 * (lane + 64 * i) + 1]; }
        float myrinv = 0.f;
        for (int r0 = 0; r0 < 32; r0 += 8) {
            u32x4 raw[8][2]; float ss[8];
#pragma unroll
            for (int r = 0; r < 8; ++r)
#pragma unroll
                for (int i = 0; i < 2; ++i) raw[r][i] = *((const u32x4*)(x1b + (size_t)(tok0 + r0 + r) * DM) + lane + 64 * i);
#pragma unroll
            for (int r = 0; r < 8; ++r) { float a = 0.f;
#pragma unroll
                for (int i = 0; i < 2; ++i)
#pragma unroll
                    for (int q = 0; q < 4; ++q) { const float lo = bf_lo(raw[r][i][q]), hi = bf_hi(raw[r][i][q]); a += lo * lo + hi * hi; }
                ss[r] = a; }
#pragma unroll
            for (int o = 32; o >= 1; o >>= 1)
#pragma unroll
                for (int r = 0; r < 8; ++r) ss[r] += __shfl_xor(ss[r], o);
#pragma unroll
            for (int r = 0; r < 8; ++r) {
                const int row = tok0 + r0 + r;
                const float rinv = 1.0f / sqrtf(ss[r] * (1.0f / DM) + NORM_EPS);
                if (c == r0 + r) myrinv = rinv;
#pragma unroll
                for (int i = 0; i < 2; ++i) {
                    float y[8];
#pragma unroll
                    for (int q = 0; q < 4; ++q) { y[2 * q] = bf_lo(raw[r][i][q]) * rinv * gv4[2 * i + (q >> 1)][2 * (q & 1)]; y[2 * q + 1] = bf_hi(raw[r][i][q]) * rinv * gv4[2 * i + (q >> 1)][2 * (q & 1) + 1]; }
                    u32x2 w; w.x = cvt4_fp8(y[0], y[1], y[2], y[3]); w.y = cvt4_fp8(y[4], y[5], y[6], y[7]);
                    *(u32x2*)(ws + WS_H2F8 + (size_t)row * DM + 8 * (lane + 64 * i)) = w;
                }
            }
        }
        f32x16 L = zero16();
        {
            const bf16_t* ap = WR + (size_t)c * DM + 8 * h;
            const bf16_t* bp = x1b + (size_t)(tok0 + c) * DM + 8 * h;
#pragma unroll 4
            for (int k0 = 0; k0 < DM; k0 += 16) {
                const u32x4 raw = *(const u32x4*)(bp + k0);
                L = MFMA32(ldfrag(ap + k0), __builtin_bit_cast(bf16x8, raw), L);
            }
        }
#pragma unroll
        for (int r = 0; r < 16; ++r) L[r] *= myrinv;
        float own[16], oth[16];
#pragma unroll
        for (int r = 0; r < 16; ++r) { own[r] = L[r] + brt[crow(r, h)]; }
#pragma unroll
        for (int r = 0; r < 16; ++r) oth[r] = __shfl_xor(own[r], 32);
        float tv[4]; int te[4];
#pragma unroll
        for (int k = 0; k < 4; ++k) {
            float best = -INFINITY; int bid = 1 << 20;
#pragma unroll
            for (int r = 0; r < 16; ++r) {
                const int e0 = crow(r, h), e1 = crow(r, 1 - h);
                if (own[r] > best || (own[r] == best && e0 < bid)) { best = own[r]; bid = e0; }
                if (oth[r] > best || (oth[r] == best && e1 < bid)) { best = oth[r]; bid = e1; }
            }
            tv[k] = best; te[k] = min(max(bid, 0), 31);
#pragma unroll
            for (int r = 0; r < 16; ++r) { if (crow(r, h) == bid) own[r] = -INFINITY; if (crow(r, 1 - h) == bid) oth[r] = -INFINITY; }
        }
        if (h == 0) {
            const float e0 = 1.0f, e1 = expf(tv[1] - tv[0]), e2 = expf(tv[2] - tv[0]), e3 = expf(tv[3] - tv[0]);
            const float inv = 1.0f / (e0 + e1 + e2 + e3);
            const int tok = tok0 + c;
            *(int4*)(topk_e + (size_t)tok * 4) = make_int4(te[0], te[1], te[2], te[3]);
            f32x4 gg; gg[0] = e0 * inv; gg[1] = e1 * inv; gg[2] = e2 * inv; gg[3] = e3 * inv;
            *(f32x4*)(topk_g + (size_t)tok * 4) = gg;
#pragma unroll
            for (int k = 0; k < 4; ++k) atomicAdd((int*)&hist[te[k]], 1);
        }
        __syncthreads();
        if (X.tid < 32) CNT[wgt * 32 + X.tid] = hist[X.tid];
        __syncthreads();
    }
}

__device__ __forceinline__ void p5_slots(const Ctx& X, const Params& P) {
    unsigned char* ws = P.ws;
    const int* CNT = (const int*)(ws + WS_CNT); int* EXPS = (int*)(ws + WS_EXP);
    const int* topk_e = (const int*)(ws + WS_TOPK_E); int* tokslot = (int*)(ws + WS_TOKSLOT); int* slottok = (int*)(ws + WS_SLOTTOK);
    LAS int* tot = (LAS int*)X.lds;
    LAS int* base = (LAS int*)X.lds + 32;
    LAS int* start = (LAS int*)X.lds + 64;
    LAS int* cur = (LAS int*)X.lds + 128;
    for (int wgt = X.wg; wgt < T_TOK / 256; wgt += X.nwg) {
        __syncthreads();
        {
            LAS int* ptot = (LAS int*)X.lds + 256; LAS int* pbase = (LAS int*)X.lds + 768;
            const int e = X.tid & 31, part = X.tid >> 5;
            int t = 0, bs = 0;
#pragma unroll
            for (int i = 0; i < 16; ++i) { const int w = part * 16 + i; const int v = CNT[w * 32 + e]; t += v; bs += (w < wgt) ? v : 0; }
            ptot[part * 32 + e] = t; pbase[part * 32 + e] = bs;
            __syncthreads();
            if (X.tid < 32) { int tt = 0, bb = 0;
#pragma unroll
                for (int q = 0; q < 16; ++q) { tt += ptot[q * 32 + X.tid]; bb += pbase[q * 32 + X.tid]; }
                tot[X.tid] = tt; base[X.tid] = bb; cur[X.tid] = 0; }
        }
        __syncthreads();
        if (X.tid == 0) { int s = 0; for (int e = 0; e < 32; ++e) { start[e] = s; s += tot[e]; } start[32] = s; }
        __syncthreads();
        if (wgt == 0) {
            if (X.tid < 33) EXPS[X.tid] = start[X.tid];
            if (X.tid < 256) slottok[NSLOT + X.tid] = 0;
        }
        if (X.tid < 256) {
            const int tok = wgt * 256 + X.tid;
            const int4 e4 = *(const int4*)(topk_e + (size_t)tok * 4);
            const int es[4] = {e4.x, e4.y, e4.z, e4.w};
            int sl[4];
#pragma unroll
            for (int k = 0; k < 4; ++k) { const int e = min(max(es[k], 0), 31); const int pos = atomicAdd((int*)&cur[e], 1); sl[k] = min(max(start[e] + base[e] + pos, 0), NSLOT - 1); slottok[sl[k]] = tok; }
            *(int4*)(tokslot + (size_t)tok * 4) = make_int4(sl[0], sl[1], sl[2], sl[3]);
        }
    }
}

constexpr size_t WS_ACT = MIB(208);
template <bool GATHER, int NPN, int PITCH, int BROWS>
struct MoeSched {
    const LAS int* desc;
    const char* A; const char* B; const int* slottok; int t1, x, k, gx;
    __device__ __forceinline__ bool next(int i, g8::Unit& u) const {
        const int j = i * gx + k, q = j / NPN, rt = x + 8 * q;
        if (rt >= t1) return false;
        const int row0 = __builtin_amdgcn_readfirstlane(desc[2 * rt]), info = __builtin_amdgcn_readfirstlane(desc[2 * rt + 1]);
        u.rt = rt; u.pn = j - q * NPN; u.e = info >> 16; u.row0 = row0; u.nvalid = info & 0xffff;
        return true;
    }
    __device__ __forceinline__ const char* a_ptr(const g8::Unit& u) const { return GATHER ? A : A + (size_t)u.row0 * PITCH; }
    __device__ __forceinline__ const char* b_ptr(const g8::Unit& u) const { return B + ((size_t)u.e * BROWS + (size_t)u.pn * 256) * PITCH; }
    __device__ __forceinline__ const int* idx_ptr(const g8::Unit& u) const { return slottok + u.row0; }
};
struct EpiGU {
    static constexpr bool PERM = true, PREFETCH = false, BIAS = true;
    const float* bgu; unsigned char* act; int rb;
    __device__ __forceinline__ void bias(const g8::Unit& u, int wc, int fq, g8::f32x4 (&nb)[2][2]) const {
        const int colbase = 128 * u.pn + 32 * wc + 8 * fq;
#pragma unroll
        for (int n = 0; n < 2; ++n) { nb[0][n] = *(const g8::f32x4*)(bgu + (size_t)u.e * 2048 + colbase + 4 * n); nb[1][n] = *(const g8::f32x4*)(bgu + (size_t)u.e * 2048 + 1024 + colbase + 4 * n) + 1.0f; }
    }
    __device__ __forceinline__ void operator()(const g8::f32x4 (&acc)[2][2][4][2], const g8::Unit& u, int wr, int wc, int fr, int fq) const {
        asm volatile("" : "+v"(fr), "+v"(fq));
        const int colst = 128 * u.pn + 32 * wc + 8 * (fq & ~1);
#pragma unroll
        for (int ai = 0; ai < 2; ++ai)
#pragma unroll
            for (int mp = 0; mp < 4; mp += 2) {
                u32x2 w[2];
#pragma unroll
                for (int q2 = 0; q2 < 2; ++q2) {
                    const int m = mp + q2;
                    float a[8];
                    typedef float f32x2e __attribute__((ext_vector_type(2)));
#pragma unroll
                    for (int n = 0; n < 2; ++n)
#pragma unroll
                        for (int q = 0; q < 4; q += 2) {
                            f32x2e g2 = (f32x2e){acc[ai][0][m][n][q], acc[ai][0][m][n][q + 1]};
                            g2[0] = __builtin_amdgcn_fmed3f(g2[0], -3.0e38f, 7.0f); g2[1] = __builtin_amdgcn_fmed3f(g2[1], -3.0e38f, 7.0f);
                            f32x2e l2 = (f32x2e){acc[ai][1][m][n][q], acc[ai][1][m][n][q + 1]};
                            l2[0] = __builtin_amdgcn_fmed3f(l2[0], -6.0f, 8.0f); l2[1] = __builtin_amdgcn_fmed3f(l2[1], -6.0f, 8.0f);
                            const f32x2e t2 = g2 * -2.4554669595930157f;
                            f32x2e d2 = (f32x2e){__builtin_amdgcn_exp2f(t2[0]), __builtin_amdgcn_exp2f(t2[1])} + 1.0f;
                            const f32x2e s2 = (f32x2e){__builtin_amdgcn_rcpf(d2[0]), __builtin_amdgcn_rcpf(d2[1])};
                            const f32x2e a2 = g2 * s2 * l2;
                            a[4 * n + q] = a2[0]; a[4 * n + q + 1] = a2[1];
                        }
                    w[q2].x = cvt4_fp8(a[0], a[1], a[2], a[3]); w[q2].y = cvt4_fp8(a[4], a[5], a[6], a[7]);
                }
                const auto rx = __builtin_amdgcn_permlane16_swap(w[0].x, w[1].x, false, false), ry = __builtin_amdgcn_permlane16_swap(w[0].y, w[1].y, false, false);
                const int r = 128 * ai + 64 * wr + 16 * (mp + (fq & 1)) + fr;
                if (r < u.nvalid) *(u32x4*)(act + (size_t)(u.row0 - rb + r) * DEXP + colst) = (u32x4){(unsigned)rx[0], (unsigned)ry[0], (unsigned)rx[1], (unsigned)ry[1]};
                asm volatile("" ::: "memory");
            }
    }
};
struct EpiDown {
    static constexpr bool PERM = true, PREFETCH = false, BIAS = true;
    const float* bdn; unsigned char* ys;
    __device__ __forceinline__ void bias(const g8::Unit& u, int wc, int fq, g8::f32x4 (&nb)[2][2]) const {
        const int colbase = 256 * u.pn + 32 * wc + 8 * fq;
#pragma unroll
        for (int bj = 0; bj < 2; ++bj)
#pragma unroll
            for (int n = 0; n < 2; ++n) nb[bj][n] = *(const g8::f32x4*)(bdn + (size_t)u.e * 1024 + colbase + 128 * bj + 4 * n);
    }
    __device__ __forceinline__ void operator()(const g8::f32x4 (&acc)[2][2][4][2], const g8::Unit& u, int wr, int wc, int fr, int fq) const {
        asm volatile("" : "+v"(fr), "+v"(fq));
        const int colst = 256 * u.pn + 32 * wc + 8 * (fq & ~1);
#pragma unroll
        for (int bj = 0; bj < 2; ++bj) {
#pragma unroll
            for (int ai = 0; ai < 2; ++ai)
#pragma unroll
                for (int mp = 0; mp < 4; mp += 2) {
                    u32x2 w[2];
#pragma unroll
                    for (int q2 = 0; q2 < 2; ++q2) { const g8::f32x4 v0 = acc[ai][bj][mp + q2][0], v1 = acc[ai][bj][mp + q2][1];
                        w[q2].x = cvt4_fp8(v0[0], v0[1], v0[2], v0[3]); w[q2].y = cvt4_fp8(v1[0], v1[1], v1[2], v1[3]); }
                    const auto rx = __builtin_amdgcn_permlane16_swap(w[0].x, w[1].x, false, false), ry = __builtin_amdgcn_permlane16_swap(w[0].y, w[1].y, false, false);
                    const int r = 128 * ai + 64 * wr + 16 * (mp + (fq & 1)) + fr;
                    if (r < u.nvalid) *(u32x4*)(ys + (size_t)(u.row0 + r) * DM + colst + 128 * bj) = (u32x4){(unsigned)rx[0], (unsigned)ry[0], (unsigned)rx[1], (unsigned)ry[1]};
                }
            asm volatile("" ::: "memory");
        }
    }
};
constexpr int LDS_TDESC = 4096 + 131072;
#define P6_ROUNDS(X, P, ldsall, bar) do { \
    unsigned char* ws_ = (P).ws; \
    LAS int* es_ = (LAS int*)((ldsall) + 64); LAS int* tp_ = (LAS int*)((ldsall) + 256); LAS int* desc_ = (LAS int*)((ldsall) + LDS_TDESC); \
    __syncthreads(); \
    if ((X).tid < 33) es_[(X).tid] = min(max(((const int*)(ws_ + WS_EXP))[(X).tid], 0), NSLOT); \
    __syncthreads(); \
    if ((X).tid == 0) { int s_ = 0; for (int e_ = 0; e_ < 32; ++e_) { tp_[e_] = s_; s_ += max(es_[e_ + 1] - es_[e_] + 255, 0) >> 8; } tp_[32] = s_; } \
    __syncthreads(); \
    const int ntile_ = min(tp_[32], 1056); \
    for (int t_ = (X).tid; t_ < ntile_; t_ += 512) { int e_ = 0; for (int kk_ = 1; kk_ < 32; ++kk_) if (tp_[kk_] <= t_) e_ = kk_; \
        const int row0_ = es_[e_] + 256 * (t_ - tp_[e_]); desc_[2 * t_] = row0_; desc_[2 * t_ + 1] = (e_ << 16) | min(256, es_[e_ + 1] - row0_); } \
    __syncthreads(); \
    { \
        { MoeSched<true, 8, 1024, 2048> S_; S_.desc = desc_; S_.slottok = (const int*)(ws_ + WS_SLOTTOK); S_.t1 = ntile_; S_.x = (X).mx; S_.k = (X).mk; S_.gx = (X).nwg >> 3; \
          S_.A = (const char*)(ws_ + WS_H2F8); S_.B = (const char*)(ws_ + WS_WGU); \
          EpiGU E_{CF(ws_, C_BGU), ws_ + WS_ACT, 0}; g8::gemm_phase<EpiGU, MoeSched<true, 8, 1024, 2048>, true, true>((ldsall) + 4096, (ldsall) + 2048, S_, E_, (X).wid); } \
        xcd_barrier(bar); \
        { MoeSched<false, 4, 1024, 1024> S_; S_.desc = desc_; S_.slottok = nullptr; S_.t1 = ntile_; S_.x = (X).mx; S_.k = (X).mk; S_.gx = (X).nwg >> 3; \
          S_.A = (const char*)(ws_ + WS_ACT); S_.B = (const char*)(ws_ + WS_WD); \
          EpiDown E_{CF(ws_, C_BDN), ws_ + WS_YS}; g8::gemm_phase<EpiDown, MoeSched<false, 4, 1024, 1024>, false, true>((ldsall) + 4096, (ldsall) + 2048, S_, E_, (X).wid); } \
        xcd_barrier(bar); \
    } } while (0)

__device__ __forceinline__ void p7_combine(const Ctx& X, const Params& P) {
    unsigned char* ws = P.ws;
    const int* tokslot = (const int*)(ws + WS_TOKSLOT); const float* topk_g = (const float*)(ws + WS_TOPK_G); const unsigned char* YS = ws + WS_YS;
    float* out = P.out; const bf16_t* x1b = (const bf16_t*)(ws + WS_X1B);
    typedef float f32x2v __attribute__((ext_vector_type(2)));
    for (int tok = X.gw; tok < T_TOK; tok += X.nw) {
        const int4 sl = *(const int4*)(tokslot + (size_t)tok * 4); const f32x4 gg = *(const f32x4*)(topk_g + (size_t)tok * 4);
        const int s4[4] = {min(max(sl.x, 0), NSLOT - 1), min(max(sl.y, 0), NSLOT - 1), min(max(sl.z, 0), NSLOT - 1), min(max(sl.w, 0), NSLOT - 1)};
#pragma unroll
        for (int half = 0; half < 2; ++half) {
            const int col = half * 512 + X.lane * 8;
            const u32x4 xw = __builtin_nontemporal_load((const u32x4*)(x1b + (size_t)tok * DM + col));
            f32x4 o0, o1; o0[0] = bf_lo(xw.x); o0[1] = bf_hi(xw.x); o0[2] = bf_lo(xw.y); o0[3] = bf_hi(xw.y); o1[0] = bf_lo(xw.z); o1[1] = bf_hi(xw.z); o1[2] = bf_lo(xw.w); o1[3] = bf_hi(xw.w);
#pragma unroll
            for (int k = 0; k < 4; ++k) {
                const u32x2 y = __builtin_nontemporal_load((const u32x2*)(YS + (size_t)s4[k] * DM + col)); const float gk = gg[k];
                const f32x2v a = __builtin_amdgcn_cvt_pk_f32_fp8((int)y.x, false), b = __builtin_amdgcn_cvt_pk_f32_fp8((int)y.x, true);
                const f32x2v c = __builtin_amdgcn_cvt_pk_f32_fp8((int)y.y, false), d = __builtin_amdgcn_cvt_pk_f32_fp8((int)y.y, true);
                o0[0] += gk * a[0]; o0[1] += gk * a[1]; o0[2] += gk * b[0]; o0[3] += gk * b[1];
                o1[0] += gk * c[0]; o1[1] += gk * c[1]; o1[2] += gk * d[0]; o1[3] += gk * d[1];
            }
            __builtin_nontemporal_store(o0, (f32x4*)(out + (size_t)tok * DM + col)); __builtin_nontemporal_store(o1, (f32x4*)(out + (size_t)tok * DM + col + 4));
        }
    }
}

constexpr int LDS_BYTES = 155648;
__global__ void __launch_bounds__(512, 2) fwd(Params P) {
    extern __shared__ __attribute__((aligned(16))) unsigned char lds[];
    const int wid0_ = __builtin_amdgcn_readfirstlane((int)threadIdx.x >> 6);
    if (threadIdx.x == 0) *(LAS u32x4*)lds = (u32x4){0u, 0u, 0u, 0u};
    __syncthreads();
    (void)xcd_barrier_post((unsigned*)(P.ws + WS_BAR), (volatile LAS unsigned*)lds, threadIdx.x == 0);
    if (threadIdx.x == 0) { const unsigned xc = xb_xcc_id(); ((LAS unsigned*)lds)[4] = xc; ((LAS unsigned*)lds)[5] = xb_add((unsigned*)(P.ws + WS_XRANK) + 64 * xc, 1u); }
#define xcd_barrier(b) xcd_barrier_((b), wid0_ == 0 && lane_id() == 0)
#define bar (XcdBarrier{(unsigned*)(P.ws + WS_BAR), xb_xcc_id(), (volatile LAS unsigned*)lds})
    Ctx X;
#define NEW_CTX() do { int l_ = lane_id(); asm volatile("" : "+v"(l_));     \
    X.lane = l_; X.wid = wid0_; X.tid = wid0_ * 64 + l_; X.c = X.lane & 31; X.h = X.lane >> 5; \
    X.wg = blockIdx.x; X.nwg = gridDim.x; X.gw = X.wg * 8 + X.wid; X.nw = X.nwg * 8; X.lds = (LAS unsigned char*)lds + 64; \
    { const LAS unsigned* m_ = (const LAS unsigned*)lds; const bool hw_ = (m_[2] != 0u) && (m_[4] < 8u) && (m_[5] < m_[0]);     \
      X.mx = __builtin_amdgcn_readfirstlane(hw_ ? (int)m_[4] : (X.wg & 7)); X.mk = __builtin_amdgcn_readfirstlane(hw_ ? (int)m_[5] : (X.wg >> 3)); } } while (0)

    NEW_CTX();
    p0_prologue(X, P);
    xcd_barrier(bar);
    NEW_CTX();
    p1_inproj_g8(X, P, (LAS unsigned char*)lds);
    xcd_barrier(bar);
    NEW_CTX();
    p2_mixers(X, P, (LAS unsigned char*)lds);
    xcd_barrier(bar);
    NEW_CTX();
    p3_outproj_g8(X, P, (LAS unsigned char*)lds);
    xcd_barrier(bar);
    NEW_CTX();
    p4_router(X, P);
    xcd_barrier(bar);
    NEW_CTX();
    p5_slots(X, P);
    xcd_barrier(bar);
    NEW_CTX();
    P6_ROUNDS(X, P, (LAS unsigned char*)lds, bar);
    NEW_CTX();
    p7_combine(X, P);
}

extern "C" void kernel_launch(void* const* d_in, const int* in_sizes, int n_in, void* d_out, int out_size, void* d_ws, size_t ws_size, hipStream_t stream) {
    static int grid = 0;
    if (grid == 0) {
        if (n_in != 22 || out_size != T_TOK * DM || ws_size < WS_END) { fprintf(stderr, "kernel_launch: unexpected shapes (n_in %d out %d ws %zu)\n", n_in, out_size, ws_size); grid = -1; return; }
        int dev = 0, cus = 0, per_cu = 0;
        if (hipGetDevice(&dev) != hipSuccess || hipDeviceGetAttribute(&cus, hipDeviceAttributeMultiprocessorCount, dev) != hipSuccess) { grid = -1; return; }
        if (hipFuncSetAttribute((const void*)fwd, hipFuncAttributeMaxDynamicSharedMemorySize, LDS_BYTES) != hipSuccess) { fprintf(stderr, "kernel_launch: hipFuncSetAttribute failed\n"); grid = -1; return; }
        if (hipOccupancyMaxActiveBlocksPerMultiprocessor(&per_cu, (const void*)fwd, 512, LDS_BYTES) != hipSuccess || per_cu < 1) { fprintf(stderr, "kernel_launch: occupancy query says %d\n", per_cu); }
        (void)hipGetLastError();
        grid = cus;
    }
    if (grid < 0) return;
    (void)hipMemsetAsync(d_ws, 0, 24576, stream);
    Params p{};
    for (int i = 0; i < 22; ++i) p.in[i] = (const float*)d_in[i];
    p.out = (float*)d_out; p.ws = (unsigned char*)d_ws;
    hipLaunchKernelGGL(fwd, dim3(grid), dim3(512), LDS_BYTES, stream, p);
}
```

```cpp
#include <hip/hip_runtime.h>
#include <stdint.h>
#include <stdio.h>

typedef unsigned short bf16_t;
typedef short bf16x8 __attribute__((ext_vector_type(8)));
typedef short s16x4 __attribute__((ext_vector_type(4)));
typedef float f32x16 __attribute__((ext_vector_type(16)));
typedef float f32x4 __attribute__((ext_vector_type(4)));
typedef unsigned u32x4 __attribute__((ext_vector_type(4)));
typedef unsigned u32x2 __attribute__((ext_vector_type(2)));

constexpr int T_TOK = 65536, DM = 1024, SEQ = 2048, NBATCH = 32;
constexpr int NGROUP = 44;
constexpr int NEXP = 32, DEXP = 1024;
constexpr int NSLOT = T_TOK * 4;
constexpr float NORM_EPS = 1e-6f;
constexpr float QSCALE = 0.125f * 1.4426950408889634f;
constexpr float IW_SCALE = 0.04419417382415922f;
constexpr float LAM_INIT = 0.2f;

#define MIB(x) ((size_t)(x) << 20)
constexpr size_t WS_BAR = 0;
constexpr size_t WS_XRANK = 16384;
constexpr size_t WS_CNT = 65536;
constexpr size_t WS_EXP = 65536 + 32768;
constexpr size_t WS_CONST = 524288;
constexpr int C_BGU = 0, C_BDN = 65536, C_GQA = 98304, C_GKA = C_GQA + 64, C_GIK = C_GQA + 128, C_LQ1 = C_GQA + 192, C_LK1 = C_GQA + 256, C_LQ2 = C_GQA + 320,
              C_LK2 = C_GQA + 384, C_GQB = C_GQA + 448, C_GKB = C_GQA + 512, C_GSUB = C_GQA + 576, C_GFFN = C_GQA + 704, C_BRT = C_GQA + 1728, C_END = C_GQA + 1760;
constexpr size_t WS_TOPK_E = MIB(1);
constexpr size_t WS_TOPK_G = MIB(2);
constexpr size_t WS_TOKSLOT = MIB(3);
constexpr size_t WS_ROPE = MIB(4);
constexpr size_t WS_SLOTTOK = MIB(4);
constexpr size_t WS_WGU = MIB(8);
constexpr size_t WS_WD = MIB(72);
constexpr size_t WS_H2F8 = MIB(104);
constexpr size_t WS_WIN = MIB(200);
constexpr size_t WS_WR = MIB(200) + 5767168;
constexpr size_t WS_WO = MIB(206);
constexpr size_t WS_H = MIB(208);
constexpr size_t WS_QA = MIB(336);
constexpr size_t WS_QI = MIB(400);
constexpr size_t WS_QB = MIB(464);
constexpr size_t WS_KB = MIB(528);
constexpr size_t WS_VBT = MIB(592);
constexpr size_t WS_KA = MIB(656);
constexpr size_t WS_VAT = MIB(664);
constexpr size_t WS_KI = MIB(672);
constexpr size_t WS_WI = MIB(680);
constexpr size_t WS_YS = MIB(512);
constexpr size_t WS_X1B = MIB(768);
constexpr size_t WS_END = MIB(1024);

#define XB_TMO      128
#define XB_XCNT(j)  (256  + 64 * (j))
#define XB_XSUB(j)  (1280 + 64 * (j))
#define XB_XGEN(j)  (2304 + 64 * (j))
#define XB_TOP      3328
#define XB_TOPGEN   3392
#define XCD_BAR_WORDS 3456
#define XB_SPIN_CAP (1u << 18)
#define LAS __attribute__((address_space(3)))

__device__ __forceinline__ unsigned xb_ld(unsigned* p)              { return __hip_atomic_load(p, __ATOMIC_RELAXED, __HIP_MEMORY_SCOPE_AGENT); }
__device__ __forceinline__ unsigned xb_add(unsigned* p, unsigned v) { return __hip_atomic_fetch_add(p, v, __ATOMIC_RELAXED, __HIP_MEMORY_SCOPE_AGENT); }
__device__ __forceinline__ unsigned xb_xcc_id() { return (unsigned)__builtin_amdgcn_s_getreg((3 << 11) | 20) & 0xFu; }
#define XB_SPIN(cond, bar) do { unsigned _sp = 0; while (cond) { __builtin_amdgcn_s_sleep(1); \
    if ((++_sp & 255u) == 0u) { if (xb_ld(&(bar)[XB_TMO])) break; if (_sp > XB_SPIN_CAP) { atomicAdd(&(bar)[XB_TMO], 1u); break; } } } } while (0)

struct XcdBarrier { unsigned* bar; unsigned x; volatile LAS unsigned* st; };

__device__ __forceinline__ XcdBarrier xcd_barrier_post(unsigned* bar, volatile LAS unsigned* st, bool t0  ) {
    XcdBarrier b; b.bar = bar; b.x = xb_xcc_id(); b.st = st;
    if (t0) (void)xb_add(&bar[XB_XCNT(b.x)], 1u);
    return b;
}
__device__ __forceinline__ bool xcd_barrier_complete(unsigned* bar, unsigned x, unsigned& nloc, unsigned& nx) {
    const unsigned G = gridDim.x * gridDim.y * gridDim.z;
    unsigned sum, cnt, mine, sp = 0u; bool uni;
    for (;;) {
        sum = 0u; cnt = 0u; mine = 0u; uni = true;
#pragma unroll
        for (unsigned j = 0; j < 16; ++j) { const unsigned c = xb_ld(&bar[XB_XCNT(j)]); sum += c; cnt += (c > 0u) ? 1u : 0u; mine = (j == x) ? c : mine; uni = uni && (c == 0u || c * 8u == G); }
        if (sum == G) break;
        __builtin_amdgcn_s_sleep(1);
        if ((++sp & 255u) == 0u) { if (xb_ld(&bar[XB_TMO])) break; if (sp > XB_SPIN_CAP) { atomicAdd(&bar[XB_TMO], 1u); break; } }
    }
    nloc = mine > 0u ? mine : 1u; nx = cnt > 0u ? cnt : 1u;
    return sum == G && cnt == 8u && uni;
}
__device__ __forceinline__ void xcd_barrier_(const XcdBarrier& b, bool t0  ) {
    asm volatile("s_waitcnt vmcnt(0)" ::: "memory");
    __syncthreads();
    if (t0) {
        unsigned* bar = b.bar;
        __builtin_amdgcn_s_waitcnt(0);
        unsigned nloc = b.st[0], nx = b.st[1];
        if (nloc == 0u) { const bool uni = xcd_barrier_complete(bar, b.x, nloc, nx); b.st[0] = nloc; b.st[1] = nx; b.st[2] = uni ? 1u : 0u; }
        const unsigned old = xb_add(&bar[XB_XSUB(b.x)], 1u);
        const unsigned gen = old / nloc;
        if (old + 1u == (gen + 1u) * nloc) {
            __builtin_amdgcn_fence(__ATOMIC_RELEASE, "agent");
            asm volatile("s_waitcnt vmcnt(0)" ::: "memory");
            const unsigned og = xb_add(&bar[XB_TOP], 1u);
            const unsigned tg = og / nx;
            if (og + 1u == (tg + 1u) * nx) xb_add(&bar[XB_TOPGEN], 1u);
            else XB_SPIN(xb_ld(&bar[XB_TOPGEN]) == tg, bar);
            __builtin_amdgcn_fence(__ATOMIC_ACQUIRE, "agent");
            xb_add(&bar[XB_XGEN(b.x)], 1u);
            asm volatile("s_waitcnt vmcnt(0)" ::: "memory");
        } else {
            XB_SPIN(xb_ld(&bar[XB_XGEN(b.x)]) == gen, bar);
            __builtin_amdgcn_fence(__ATOMIC_ACQUIRE, "agent");
            asm volatile("s_waitcnt vmcnt(0)" ::: "memory");
        }
    }
    __syncthreads();
}

#define MFMA32(a, b, c) __builtin_amdgcn_mfma_f32_32x32x16_bf16((a), (b), (c), 0, 0, 0)
__device__ __forceinline__ int crow(int r, int h) { return (r & 3) + 8 * (r >> 2) + 4 * h; }
typedef __bf16 bf16x2_t __attribute__((ext_vector_type(2)));
typedef float f32x2_t __attribute__((ext_vector_type(2)));
__device__ __forceinline__ unsigned cvt_pk_bf16(float lo, float hi) { f32x2_t v; v.x = lo; v.y = hi; return __builtin_bit_cast(unsigned, __builtin_convertvector(v, bf16x2_t)); }

typedef int v8i32 __attribute__((ext_vector_type(8)));
constexpr float W8_SCALE = 32.0f;
constexpr int W8_E8M0 = 127 - 5, ONE_E8M0 = 127;
__device__ __forceinline__ unsigned cvt4_fp8(float a, float b, float c, float d) { int w = __builtin_amdgcn_cvt_pk_fp8_f32(a, b, 0, false); w = __builtin_amdgcn_cvt_pk_fp8_f32(c, d, w, true); return (unsigned)w; }
__device__ __forceinline__ float wave_sum(float v) {
#pragma unroll
    for (int o = 32; o >= 1; o >>= 1) v += __shfl_xor(v, o);
    return v;
}
__device__ __forceinline__ bf16x8 ldfrag(const bf16_t* p) { return *reinterpret_cast<const bf16x8*>(p); }
__device__ __forceinline__ bf16x8 pack8(const f32x16& v, int base) {
    u32x4 w; w.x = cvt_pk_bf16(v[base + 0], v[base + 1]); w.y = cvt_pk_bf16(v[base + 2], v[base + 3]);
    w.z = cvt_pk_bf16(v[base + 4], v[base + 5]); w.w = cvt_pk_bf16(v[base + 6], v[base + 7]);
    return __builtin_bit_cast(bf16x8, w);
}
__device__ __forceinline__ f32x16 zero16() { f32x16 z;
#pragma unroll
    for (int i = 0; i < 16; ++i) z[i] = 0.f; return z; }


struct Params {
    const float* in[22];
    float* out;
    unsigned char* ws;
};

#define CF(ws, off) ((const float*)((ws) + WS_CONST) + (off))

__device__ __forceinline__ int lane_id() { unsigned z = 0; asm volatile("" : "+v"(z));
    return (int)__builtin_amdgcn_mbcnt_hi(~0u, __builtin_amdgcn_mbcnt_lo(~0u, z)); }

__device__ __forceinline__ float bf_lo(unsigned w) { return __uint_as_float(w << 16); }
__device__ __forceinline__ float bf_hi(unsigned w) { return __uint_as_float(w & 0xffff0000u); }
struct Ctx {
    int tid, lane, wid, c, h, gw, nw, wg, nwg, mx, mk;
    LAS unsigned char* lds;
};

__device__ __forceinline__ void p0_rmsnorm_rows(const Ctx& X, const float* __restrict__ x, const float* __restrict__ g, bf16_t* __restrict__ H) {
    f32x4 gv[4];
#pragma unroll
    for (int i = 0; i < 4; ++i) gv[i] = ((const f32x4*)g)[X.lane + 64 * i];
    for (int base = X.gw * 4; base < T_TOK; base += X.nw * 4) {
        f32x4 v[4][4]; float ss[4];
#pragma unroll
        for (int r = 0; r < 4; ++r)
#pragma unroll
            for (int i = 0; i < 4; ++i) v[r][i] = __builtin_nontemporal_load((const f32x4*)(x + (size_t)(base + r) * DM) + X.lane + 64 * i);
#pragma unroll
        for (int r = 0; r < 4; ++r) { float a = 0.f;
#pragma unroll
            for (int i = 0; i < 4; ++i) a += v[r][i][0] * v[r][i][0] + v[r][i][1] * v[r][i][1] + v[r][i][2] * v[r][i][2] + v[r][i][3] * v[r][i][3];
            ss[r] = a; }
#pragma unroll
        for (int o = 32; o >= 1; o >>= 1)
#pragma unroll
            for (int r = 0; r < 4; ++r) ss[r] += __shfl_xor(ss[r], o);
#pragma unroll
        for (int r = 0; r < 4; ++r) {
            const float rinv = 1.0f / sqrtf(ss[r] * (1.0f / DM) + NORM_EPS);
#pragma unroll
            for (int i = 0; i < 4; ++i) {
                u32x2 w; w.x = cvt_pk_bf16(v[r][i][0] * rinv * gv[i][0], v[r][i][1] * rinv * gv[i][1]); w.y = cvt_pk_bf16(v[r][i][2] * rinv * gv[i][2], v[r][i][3] * rinv * gv[i][3]);
                *(u32x2*)(H + (size_t)(base + r) * DM + 4 * (X.lane + 64 * i)) = w;
            }
        }
    }
}

__device__ __forceinline__ void transpose_tile(const Ctx& X, const float* __restrict__ src, int ldsrc, int c0, int nvalid, int k0, bf16_t* __restrict__ dst, int ldd, int n0, int n0b = -1, const float* __restrict__ kscale = nullptr) {
    LAS float* tile = (LAS float*)X.lds;
    const int col = X.tid & 63, r0 = X.tid >> 6;
#pragma unroll
    for (int i = 0; i < 8; ++i) { const int row = r0 + 8 * i; float t_ = (col < nvalid) ? __builtin_nontemporal_load(src + (size_t)(k0 + row) * ldsrc + c0 + col) : 0.f; if (kscale) t_ *= kscale[k0 + row]; tile[row * 65 + col] = t_; }
    __syncthreads();
    const int nrow = X.tid >> 3, kseg = X.tid & 7;
    float v[8];
#pragma unroll
    for (int k = 0; k < 8; ++k) v[k] = tile[(kseg * 8 + k) * 65 + nrow];
    u32x4 w; w.x = cvt_pk_bf16(v[0], v[1]); w.y = cvt_pk_bf16(v[2], v[3]); w.z = cvt_pk_bf16(v[4], v[5]); w.w = cvt_pk_bf16(v[6], v[7]);
    const int drow = (n0b >= 0 && nrow >= 32) ? (n0b + nrow - 32) : (n0 + nrow);
    *(u32x4*)(dst + (size_t)drow * ldd + k0 + kseg * 8) = w;
    __syncthreads();
}

__device__ __forceinline__ void transpose_tile8(const Ctx& X, const float* __restrict__ src, int ldsrc, int c0, int k0, unsigned char* __restrict__ dst8, int ldd, int n0) {
    LAS float* tile = (LAS float*)X.lds;
    const int col = X.tid & 63, r0 = X.tid >> 6;
#pragma unroll
    for (int i = 0; i < 8; ++i) { const int row = r0 + 8 * i; tile[row * 65 + col] = __builtin_nontemporal_load(src + (size_t)(k0 + row) * ldsrc + c0 + col); }
    __syncthreads();
    const int nrow = X.tid >> 3, kseg = X.tid & 7;
    float v[8];
#pragma unroll
    for (int k = 0; k < 8; ++k) v[k] = tile[(kseg * 8 + k) * 65 + nrow] * W8_SCALE;
    u32x2 w; w.x = cvt4_fp8(v[0], v[1], v[2], v[3]); w.y = cvt4_fp8(v[4], v[5], v[6], v[7]);
    *(u32x2*)(dst8 + (size_t)(n0 + nrow) * ldd + k0 + kseg * 8) = w;
    __syncthreads();
}
__device__ __forceinline__ void win_group_src(int g, int& c0, int& nvalid) {
    nvalid = 64;
    if (g < 8) c0 = 64 * g;
    else if (g < 16) c0 = 640 + 64 * (g - 8);
    else if (g < 24) c0 = 1224 + 64 * (g - 16);
    else if (g < 32) c0 = 1736 + 64 * (g - 24);
    else if (g < 40) c0 = 2248 + 64 * (g - 32);
    else if (g == 40) c0 = 512;
    else if (g == 41) c0 = 576;
    else if (g == 42) c0 = 1152;
    else { c0 = 1216; nvalid = 8; }
}

__device__ __forceinline__ void p0_prologue(const Ctx& X, const Params& P) {
    unsigned char* ws = P.ws;
    {
        float* cst = (float*)(ws + WS_CONST);
        for (int i = X.wg * 512 + X.tid; i < C_END; i += X.nwg * 512) {
            float v;
            if (i < C_BDN) v = P.in[19][i];
            else if (i < C_GQA) v = P.in[21][i - C_BDN];
            else if (i < C_GKA) v = P.in[4][i - C_GQA];
            else if (i < C_GIK) v = P.in[5][i - C_GKA];
            else if (i < C_LQ1) v = P.in[6][i - C_GIK];
            else if (i < C_LK1) v = P.in[7][i - C_LQ1];
            else if (i < C_LQ2) v = P.in[8][i - C_LK1];
            else if (i < C_LK2) v = P.in[9][i - C_LQ2];
            else if (i < C_GQB) v = P.in[10][i - C_LK2];
            else if (i < C_GKB) v = P.in[11][i - C_GQB];
            else if (i < C_GSUB) v = P.in[12][i - C_GKB];
            else if (i < C_GFFN) v = P.in[13][i - C_GSUB];
            else if (i < C_BRT) v = P.in[15][i - C_GFFN];
            else v = P.in[17][i - C_BRT];
            cst[i] = v;
        }
    }
    p0_rmsnorm_rows(X, P.in[0], P.in[2], (bf16_t*)(ws + WS_H));
    {
        const int* pos = (const int*)P.in[1]; float* rope = (float*)(ws + WS_ROPE);
        for (int idx = X.wg * 512 + X.tid; idx < T_TOK * 8; idx += X.nwg * 512) {
            const int tok = idx >> 3, i = idx & 7;
            const float invf = i == 0 ? 1.0f : i == 1 ? 0.1939227432012558f : i == 2 ? 0.03760603070259094f : i == 3 ? 0.007292664609849453f : i == 4 ? 0.0014142135623842478f
                             : i == 5 ? 0.00027424818836152554f : i == 6 ? 5.3182957344688475e-05f : 1.0313385246263351e-05f;
            const float ang = (float)pos[tok] * invf;
            rope[tok * 16 + i] = cosf(ang); rope[tok * 16 + 8 + i] = sinf(ang);
        }
    }
    {
        const int ntile = 32 * 32 * 16;
        for (int t = X.wg; t < ntile; t += X.nwg) {
            const int kt = t & 15, q = (t >> 4) & 31, e = t >> 9;
            const int u = q >> 2, w = q & 3; const int c0 = (w < 2) ? (128 * u + 64 * w) : (1024 + 128 * u + 64 * (w - 2));
            transpose_tile8(X, P.in[18] + (size_t)e * 1024 * 2048, 2048, c0, kt * 64, ws + WS_WGU + (size_t)e * 2048 * 1024, 1024, q * 64);
        }
    }
    {
        const int ntile = 32 * 16 * 16;
        for (int t = X.wg; t < ntile; t += X.nwg) {
            const int kt = t & 15, q = (t >> 4) & 15, e = t >> 8;
            transpose_tile8(X, P.in[20] + (size_t)e * 1024 * 1024, 1024, q * 64, kt * 64, ws + WS_WD + (size_t)e * 1024 * 1024, 1024, q * 64);
        }
    }
    {
        const int ntile = NGROUP * 16;
        for (int t = X.wg; t < ntile; t += X.nwg) {
            const int kt = t & 15, g = t >> 4; int c0, nv; win_group_src(g, c0, nv);
            transpose_tile(X, P.in[3], 2760, c0, nv, kt * 64, (bf16_t*)(ws + WS_WIN), 1024, 256 * (g >> 2) + 32 * (g & 3), 256 * (g >> 2) + 128 + 32 * (g & 3));
        }
    }
    {
        for (int t = X.wg; t < 256; t += X.nwg) { const int kt = t & 15, q = t >> 4; transpose_tile(X, P.in[14], 1024, q * 64, 64, kt * 64, (bf16_t*)(ws + WS_WO), 1024, q * 64); }
    }
    {
        for (int t = X.wg; t < 16; t += X.nwg) transpose_tile(X, P.in[16], 32, 0, 32, t * 64, (bf16_t*)(ws + WS_WR), 1024, 0, -1, P.in[15]);
    }
}

typedef short v4i16_t __attribute__((ext_vector_type(4)));
__device__ __forceinline__ s16x4 tr16(const LAS unsigned char* p) { return __builtin_bit_cast(s16x4, __builtin_amdgcn_ds_read_tr16_b64_v4i16((LAS v4i16_t*)p)); }
__device__ __forceinline__ void dma16(const void* g, LAS unsigned char* l) {
    const unsigned base = (unsigned)__builtin_amdgcn_readfirstlane((int)(unsigned)(uintptr_t)l); unsigned sv;
    asm volatile("s_mov_b32 %0, m0\n\ts_mov_b32 m0, %2\n\ts_nop 0\n\tglobal_load_lds_dwordx4 %1, off\n\ts_mov_b32 m0, %0" : "=&s"(sv) : "v"(g), "s"(base) : "memory"); }
__device__ __forceinline__ bf16x8 ldsfrag(const LAS unsigned char* p) { return *(const LAS bf16x8*)p; }
constexpr int L2_FB = 1024, L2_CB = 5120, L2_ZM = 9216  , L2_WL = 17408, L2_ZT = 18432, L2_QI = 20480, L2_M8 = 20480  ,
              L2_XB = 20480  , L2_KIW = 53248  , L2_KVB = 86016  , L2_DIFF = 20480;


__device__ __forceinline__ void count_ge4(int& c0, int& c1, float x0, float x1, float x2, float x3, float t) {
    unsigned long long m0, m1, m2, m3;
    asm volatile("v_cmp_ge_f32_e64 %2, %6, %10\n\tv_cmp_ge_f32_e64 %3, %7, %10\n\tv_cmp_ge_f32_e64 %4, %8, %10\n\tv_cmp_ge_f32_e64 %5, %9, %10\n\t"
                 "v_addc_co_u32_e64 %0, vcc, 0, %0, %2\n\tv_addc_co_u32_e64 %1, vcc, 0, %1, %3\n\tv_addc_co_u32_e64 %0, vcc, 0, %0, %4\n\tv_addc_co_u32_e64 %1, vcc, 0, %1, %5"
                 : "+v"(c0), "+v"(c1), "=&s"(m0), "=&s"(m1), "=&s"(m2), "=&s"(m3) : "v"(x0), "v"(x1), "v"(x2), "v"(x3), "v"(t) : "vcc");
}

__device__ __forceinline__ void dsa_unit(const Ctx& X, const Params& P, LAS unsigned char* ldsall, int b, int qt) {
    unsigned char* ws = P.ws;
    const bf16_t* QI = (const bf16_t*)(ws + WS_QI); const bf16_t* KI = (const bf16_t*)(ws + WS_KI); const float* WI = (const float*)(ws + WS_WI);
    const bf16_t* QA = (const bf16_t*)(ws + WS_QA); const bf16_t* KA = (const bf16_t*)(ws + WS_KA); const bf16_t* VA = (const bf16_t*)(ws + WS_VAT);
    bf16_t* Y = (bf16_t*)(ws + WS_H);
    const int wid = X.wid, lane = lane_id(), c = lane & 31, h = lane >> 5;
    const int q0 = qt * 32, chunk = q0 >> 6, nkb = 2 * (chunk + 1);
    const int tokq = b * SEQ + q0 + c;
    LAS float* fb = (LAS float*)(ldsall + L2_FB);
    LAS int* cb = (LAS int*)(ldsall + L2_CB);
    LAS unsigned char* m8 = ldsall + L2_M8;
    LAS unsigned char* qis = ldsall + L2_QI;
    LAS unsigned char* kv = ldsall + L2_KVB;
#define KVSLOT(tt) (kv + (((tt) + 2) % 3) * 16384)
    __syncthreads();
    const bf16_t* ksrc = KA + (size_t)b * 131072 + wid * 512 + lane * 8;
    const bf16_t* vsrc = VA + (size_t)(b * SEQ + 16 * (wid & 3) + (lane >> 2)) * 64 + (wid >> 2) * 32 + (lane & 3) * 8;
    dma16(ksrc, KVSLOT(0) + wid * 1024); dma16(vsrc, KVSLOT(0) + 8192 + wid * 1024);
    if (nkb <= 8) {
        *(LAS u32x4*)(m8 + (wid * 64 + lane) * 16) = (u32x4){0u, 0u, 0u, 0u};
    } else {
        LAS float* wl = (LAS float*)(ldsall + L2_WL);
        if (wid == 0 && h == 0) { *(LAS f32x4*)(wl + c * 8) = *(const f32x4*)(WI + (size_t)tokq * 8); *(LAS f32x4*)(wl + c * 8 + 4) = *(const f32x4*)(WI + (size_t)tokq * 8 + 4); }
#pragma unroll
        for (int i = 0; i < 4; ++i) { const int piece = wid * 4 + i, head = piece >> 2, cp = piece & 3;
            dma16(QI + (size_t)(b * SEQ + q0 + (lane & 31)) * 512 + head * 64 + (2 * cp + (lane >> 5)) * 8, qis + piece * 1024); }
        asm volatile("s_waitcnt vmcnt(0)" ::: "memory");
        __syncthreads();
        f32x16 sc[8];
        LAS unsigned char* kiw = ldsall + L2_KIW + wid * 8192;
        const bf16_t* kisrc = KI + (size_t)b * 131072 + lane * 8;
#define KI_DMA(kb_, buf_) do { _Pragma("unroll") for (int j_ = 0; j_ < 4; ++j_) dma16(kisrc + (size_t)(kb_) * 2048 + 512 * j_, kiw + (buf_) * 4096 + j_ * 1024); } while (0)
        KI_DMA(wid, 0);
#pragma unroll
        for (int i = 0; i < 8; ++i) {
            const int kb = wid + 8 * i;
            f32x16 a = zero16();
            if (kb < nkb) {
                if (i < 7 && kb + 8 < nkb) { KI_DMA(kb + 8, (i + 1) & 1); asm volatile("s_waitcnt vmcnt(4)" ::: "memory"); }
                else asm volatile("s_waitcnt vmcnt(0)" ::: "memory");
                const LAS unsigned char* kbuf = kiw + (i & 1) * 4096;
                bf16x8 kf[4];
#pragma unroll
                for (int s = 0; s < 4; ++s) kf[s] = ldsfrag(kbuf + (2 * s + h) * 512 + c * 16);
                float wcur = wl[c * 8];
#pragma unroll 1
                for (int hd = 0; hd < 8; ++hd) {
                    const float wnext = wl[c * 8 + ((hd + 1) & 7)];
                    f32x16 S = zero16();
#pragma unroll
                    for (int s = 0; s < 4; ++s) S = MFMA32(kf[s], ldsfrag(qis + hd * 4096 + (2 * s + h) * 512 + c * 16), S);
#pragma unroll
                    for (int r = 0; r < 16; ++r) { const float rl = __builtin_amdgcn_fmed3f(S[r], 0.0f, 3.0e38f);
                        asm("v_fmac_f32 %0, %1, %2" : "+v"(a[r]) : "v"(wcur), "v"(rl)); }
                    wcur = wnext;
                }
            } else {
#pragma unroll
                for (int r = 0; r < 16; ++r) a[r] = -INFINITY;
            }
            sc[i] = a;
        }
#undef KI_DMA
        const int cq = 4 * wid + (lane >> 4), pl = lane & 15;
        {
            LAS unsigned char* xw = ldsall + L2_XB + (2 * wid + h) * 2064 + c * 64; const int swz_w = (c >> 2) & 3;
            LAS unsigned char* xr = ldsall + L2_XB + pl * 2064 + cq * 64; const int swz_r = (cq >> 2) & 3;
            __syncthreads();
#pragma unroll
            for (int i = 0; i < 8; ++i) if (8 * i < nkb) {
#pragma unroll
                for (int q4 = 0; q4 < 4; ++q4) *(LAS f32x4*)(xw + (i & 1) * 33024 + 16 * (q4 ^ swz_w)) = (f32x4){sc[i][4 * q4], sc[i][4 * q4 + 1], sc[i][4 * q4 + 2], sc[i][4 * q4 + 3]};
                __syncthreads();
#pragma unroll
                for (int q4 = 0; q4 < 4; ++q4) { const f32x4 v = *(const LAS f32x4*)(xr + (i & 1) * 33024 + 16 * (q4 ^ swz_r)); sc[i][4 * q4] = v[0]; sc[i][4 * q4 + 1] = v[1]; sc[i][4 * q4 + 2] = v[2]; sc[i][4 * q4 + 3] = v[3]; }
            }
            __syncthreads();
        }
#define DPP_I(x, ctrl) __builtin_amdgcn_update_dpp(0, (x), (ctrl), 0xF, 0xF, true)
#define DPP_F(x, ctrl) __int_as_float(DPP_I(__float_as_int(x), (ctrl)))
        float mn = INFINITY, mx = -INFINITY;
#pragma unroll
        for (int i = 0; i < 8; ++i) if (8 * i < nkb) {
            const bool val = (pl >> 1) + 8 * i < nkb;
#pragma unroll
            for (int r = 0; r < 16; ++r) { mn = fminf(mn, val ? sc[i][r] : INFINITY); mx = fmaxf(mx, sc[i][r]); }
        }
        mn = fminf(mn, DPP_F(mn, 0xB1)); mn = fminf(mn, DPP_F(mn, 0x4E)); mn = fminf(mn, DPP_F(mn, 0x141)); mn = fminf(mn, DPP_F(mn, 0x140));
        mx = fmaxf(mx, DPP_F(mx, 0xB1)); mx = fmaxf(mx, DPP_F(mx, 0x4E)); mx = fmaxf(mx, DPP_F(mx, 0x141)); mx = fmaxf(mx, DPP_F(mx, 0x140));
        float lo = mn, hi = mx;
        bool done = false; float thr = lo; int tot0 = 0;
        LAS int* ztl = (LAS int*)(ldsall + L2_ZT) + wid * 64 + lane;
        int nval = 0;
#pragma unroll
        for (int i = 0; i < 8; ++i) nval += (8 * i < nkb) ? 16 : 0;
        for (int it = 0; it < 66; ++it) {
            const float mid = 0.5f * lo + 0.5f * hi;
            const bool degenerate = !(mid > lo && mid < hi);
            const float t = done ? thr : (it == 0 ? 1e-30f : (it == 1 ? 0.0f : mid));
            unsigned a0 = 0u, a1 = 0u, a2 = 0u, a3 = 0u; const f32x2_t tt = (f32x2_t){t, t};
#pragma unroll
            for (int i = 0; i < 8; ++i) if (8 * i < nkb) {
#pragma unroll
                for (int r = 0; r < 16; r += 4) {
                    const f32x2_t d01 = (f32x2_t){sc[i][r], sc[i][r + 1]} - tt, d23 = (f32x2_t){sc[i][r + 2], sc[i][r + 3]} - tt;
                    a0 = __builtin_amdgcn_alignbit(a0, __float_as_uint(d01.x), 31); a1 = __builtin_amdgcn_alignbit(a1, __float_as_uint(d01.y), 31);
                    a2 = __builtin_amdgcn_alignbit(a2, __float_as_uint(d23.x), 31); a3 = __builtin_amdgcn_alignbit(a3, __float_as_uint(d23.y), 31);
                }
            }
            int tot = nval - (__builtin_popcount(a0) + __builtin_popcount(a1) + __builtin_popcount(a2) + __builtin_popcount(a3));
            tot += DPP_I(tot, 0xB1); tot += DPP_I(tot, 0x4E); tot += DPP_I(tot, 0x141); tot += DPP_I(tot, 0x140);
#define ZERO_PROBES(c0, c1) do { *ztl = ((c0) > 256 && (c1) < 256) ? 256 - (c1) : -1; \
                if ((c0) >= 256 && (c1) < 256) { done = true; thr = 0.0f; } \
                else if ((c1) >= 256) { lo = fmaxf(lo, 1e-30f); if ((c1) == 256) { done = true; thr = 1e-30f; } } \
                else hi = fminf(hi, 0.0f); } while (0)
            if (it == 0) { tot0 = tot;
                if (!__any(tot < 256)) { ZERO_PROBES(tot, tot); it = 1; } }
            else if (it == 1) ZERO_PROBES(tot, tot0);
            else if (!done) {
                if (degenerate) { done = true; thr = lo; }
                else if (tot == 256) { done = true; thr = mid; }
                else if (tot > 256) lo = mid; else hi = mid;
            }
#undef ZERO_PROBES
            if (__all(done)) break;
        }
#undef DPP_I
#undef DPP_F
        if (!done) thr = lo;
        const int ztake = *ztl; const bool tie = ztake >= 0;
        const int hn = pl & 1;
#pragma unroll
        for (int i = 0; i < 8; ++i) if (8 * i < nkb) {
            u32x4 w = (u32x4){0u, 0u, 0u, 0u};
#pragma unroll
            for (int r = 0; r < 16; ++r) w[r >> 2] |= (sc[i][r] >= thr) ? 0u : (0xFEu << (8 * (r & 3)));
            *(LAS u32x4*)(m8 + ((pl + 16 * i) * 32 + cq) * 16) = w;
        }
        if (__any(tie)) {
            LAS unsigned short* zmask16 = (LAS unsigned short*)(ldsall + L2_ZM);
#pragma unroll
            for (int i = 0; i < 8; ++i) if (8 * i < nkb) {
                unsigned z = 0;
#pragma unroll
                for (int r = 0; r < 16; ++r) z |= (sc[i][r] == 0.0f) ? (1u << r) : 0u;
                zmask16[cq * 128 + pl + 16 * i] = (unsigned short)z;
            }
            asm volatile("s_waitcnt lgkmcnt(0)" ::: "memory");
            const LAS unsigned* zw = (const LAS unsigned*)(ldsall + L2_ZM);
            int prefix = 0, kdone = 0;
#pragma unroll 1
            for (int kb = pl >> 1; kb < nkb; kb += 8) {
#pragma unroll 1
                for (; kdone < kb; ++kdone) prefix += __builtin_popcount(zw[cq * 64 + kdone]);
                const unsigned w = zw[cq * 64 + kb], b0 = w & 0xffffu, b1 = w >> 16;
                unsigned W = 0;
#pragma unroll
                for (int g = 0; g < 4; ++g) W |= (((b0 >> (4 * g)) & 0xfu) << (8 * g)) | (((b1 >> (4 * g)) & 0xfu) << (8 * g + 4));
                const unsigned mine = hn ? b1 : b0; unsigned add = 0;
#pragma unroll
                for (int r = 0; r < 16; ++r) { const int rho = crow(r, hn); const int rank = prefix + __builtin_popcount(W & ((1u << rho) - 1u)); add |= (((mine >> r) & 1u) && rank >= ztake) ? (1u << r) : 0u; }
                if (tie) { LAS u32x4* mp_ = (LAS u32x4*)(m8 + ((kb * 2 + hn) * 32 + cq) * 16); u32x4 w2 = *mp_;
#pragma unroll
                    for (int r = 0; r < 16; ++r) w2[r >> 2] |= (0u - ((add >> r) & 1u)) & (0xFEu << (8 * (r & 3)));
                    *mp_ = w2; }
            }
        }
    }
    {
        const bf16_t* qp = QA + (size_t)tokq * 512 + wid * 64 + 8 * h;
        bf16x8 qr[4];
#pragma unroll
        for (int s = 0; s < 4; ++s) qr[s] = ldfrag(qp + 16 * s);
        asm volatile("" : "+v"(qr[0]), "+v"(qr[1]), "+v"(qr[2]), "+v"(qr[3]));
        f32x16 O[2]; O[0] = zero16(); O[1] = zero16(); float l = 0.f;
        const int vbase = ((lane >> 4) & 1) * 32 + (lane & 3) * 8 + (4 * h + ((lane & 15) >> 2)) * 64;
        const int lane2 = lane_id();
        const bf16_t* ksrc2 = KA + (size_t)b * 131072 + wid * 512 + lane2 * 8;
        const bf16_t* vsrc2 = VA + (size_t)(b * SEQ + 16 * (wid & 3) + (lane2 >> 2)) * 64 + (wid >> 2) * 32 + (lane2 & 3) * 8;
#define DSA_DMA(tt) do { LAS unsigned char* ns_ = KVSLOT(tt); dma16(ksrc2 + (size_t)(tt) * 4096, ns_ + wid * 1024); dma16(vsrc2 + (size_t)(tt) * 64 * 64, ns_ + 8192 + wid * 1024); } while (0)
        if (chunk >= 1) DSA_DMA(1);
        for (int t = 0; t <= chunk; ++t) {
            if (t + 1 <= chunk) asm volatile("s_waitcnt vmcnt(2)" ::: "memory"); else asm volatile("s_waitcnt vmcnt(0)" ::: "memory");
            __syncthreads();
            if (t + 2 <= chunk) DSA_DMA(t + 2);
            const LAS unsigned char* ks = KVSLOT(t) + (h * 1024 + c * 16); const LAS unsigned char* vs = KVSLOT(t) + 8192 + vbase;
            asm volatile("" : "+v"(ks), "+v"(vs));
            f32x16 S[2];
            bf16x8 kf[8], vf[8];
            u32x4 mw[2];
#pragma unroll
            for (int blk = 0; blk < 2; ++blk) mw[blk] = *(const LAS u32x4*)(m8 + (((2 * t + blk) * 2 + h) * 32 + c) * 16);
#pragma unroll
            for (int i = 0; i < 8; ++i) kf[i] = ldsfrag(ks + 2048 * (i & 3) + 512 * (i >> 2));
#pragma unroll
            for (int blk = 0; blk < 2; ++blk) {
                f32x16 a;
#pragma unroll
                for (int r = 0; r < 16; ++r) a[r] = __uint_as_float(mw[blk][r >> 2] << (24 - 8 * (r & 3)));
#pragma unroll
                for (int s = 0; s < 4; ++s) a = MFMA32(kf[4 * blk + s], qr[s], a);
                S[blk] = a;
            }
#pragma unroll
            for (int i = 0; i < 8; ++i) { const s16x4 v0 = tr16(vs + (i & 1) * 4096 + (i >> 1) * 1024), v1 = tr16(vs + (i & 1) * 4096 + (i >> 1) * 1024 + 512);
                vf[i] = (bf16x8){v0[0], v0[1], v0[2], v0[3], v1[0], v1[1], v1[2], v1[3]}; }
            __builtin_amdgcn_sched_barrier(0);
#pragma unroll
            for (int blk = 0; blk < 2; ++blk)
#pragma unroll
                for (int r = 0; r < 16; ++r) { const float p = __builtin_amdgcn_exp2f(S[blk][r]); l += p; S[blk][r] = p; }
            bf16x8 pf[4];
#pragma unroll
            for (int s4 = 0; s4 < 4; ++s4) pf[s4] = pack8(S[s4 >> 1], 8 * (s4 & 1));
            __builtin_amdgcn_sched_barrier(0);
#pragma unroll
            for (int i = 0; i < 8; ++i) O[i & 1] = MFMA32(vf[i], pf[i >> 1], O[i & 1]);
        }
#undef DSA_DMA
#undef KVSLOT
        l += __shfl_xor(l, 32);
        const float inv = 1.0f / l;
        int hh = h; asm volatile("" : "+v"(hh));
        bf16_t* yrow = Y + (size_t)tokq * DM + wid * 64;
        u32x2 w[8];
#pragma unroll
        for (int db = 0; db < 2; ++db)
#pragma unroll
            for (int rg = 0; rg < 4; ++rg) { w[4 * db + rg].x = cvt_pk_bf16(O[db][4 * rg] * inv, O[db][4 * rg + 1] * inv); w[4 * db + rg].y = cvt_pk_bf16(O[db][4 * rg + 2] * inv, O[db][4 * rg + 3] * inv); }
        unsigned char* yb = (unsigned char*)yrow + 16 * hh;
#pragma unroll
        for (int k = 0; k < 8; k += 2) {
            const auto rx = __builtin_amdgcn_permlane32_swap(w[k].x, w[k + 1].x, false, false), ry = __builtin_amdgcn_permlane32_swap(w[k].y, w[k + 1].y, false, false);
            *(u32x4*)(yb + 16 * k) = (u32x4){(unsigned)rx[0], (unsigned)ry[0], (unsigned)rx[1], (unsigned)ry[1]};
        }
    }
}

__device__ __forceinline__ void diff_unit(const Ctx& X, const Params& P, LAS unsigned char* ldsall, int b, int hb, int qt16, float lam) {
    unsigned char* ws = P.ws;
    const bf16_t* QB = (const bf16_t*)(ws + WS_QB); const bf16_t* KB = (const bf16_t*)(ws + WS_KB); const bf16_t* VB = (const bf16_t*)(ws + WS_VBT);
    bf16_t* Y = (bf16_t*)(ws + WS_H);
    const float* gsub = CF(ws, C_GSUB);
    const int wid = X.wid, lane = lane_id(), c = lane & 31, h = lane >> 5, qg = wid & 3, mp = wid >> 2;
    const int q0 = qt16 * 128 + 32 * qg, chunk = q0 >> 6, ntile = 2 * qt16 + 2;
    const int tokq = b * SEQ + q0 + c;
    LAS unsigned char* ring = ldsall + L2_DIFF;
    bf16x8 qf[4];
    { const bf16_t* qp = QB + (size_t)tokq * 512 + hb * 128 + mp * 64 + 8 * h;
#pragma unroll
      for (int s = 0; s < 4; ++s) qf[s] = ldfrag(qp + 16 * s); }
    asm volatile("" : "+v"(qf[0]), "+v"(qf[1]), "+v"(qf[2]), "+v"(qf[3]));
    const bf16_t* k1src = KB + (size_t)((b * 4 + hb) * 2) * 131072 + wid * 512 + lane * 8;
    const bf16_t* vsrc0 = VB + (size_t)(b * SEQ + 16 * (wid & 3) + (lane >> 2)) * 512 + hb * 128 + (wid >> 2) * 32 + (lane & 3) * 8;
    __syncthreads();
#define DIFF_DMA(tt) do { LAS unsigned char* ns_ = ring + ((tt) % 3) * 32768; const bf16_t* kn_ = k1src + (size_t)(tt) * 4096; const bf16_t* vn_ = vsrc0 + (size_t)(tt) * 64 * 512; \
        dma16(kn_, ns_ + wid * 1024); dma16(kn_ + 131072, ns_ + 8192 + wid * 1024); dma16(vn_, ns_ + 16384 + wid * 1024); dma16(vn_ + 64, ns_ + 16384 + (wid + 8) * 1024); } while (0)
    DIFF_DMA(0); if (ntile > 1) DIFF_DMA(1);
    f32x16 O[4];
#pragma unroll
    for (int db = 0; db < 4; ++db) O[db] = zero16();
    float l = 0.f;
    const int vbase = ((lane >> 4) & 1) * 32 + (lane & 3) * 8 + (4 * h + ((lane & 15) >> 2)) * 64;
    for (int t = 0; t < ntile; ++t) {
        if (t + 1 < ntile) asm volatile("s_waitcnt vmcnt(4)" ::: "memory"); else asm volatile("s_waitcnt vmcnt(0)" ::: "memory");
        __syncthreads();
        if (t + 2 < ntile) DIFF_DMA(t + 2);
        if (t <= chunk) {
            const LAS unsigned char* ks = ring + (t % 3) * 32768 + mp * 8192 + (h * 1024 + c * 16); const LAS unsigned char* vs = ring + (t % 3) * 32768 + 16384 + vbase;
            asm volatile("" : "+v"(ks), "+v"(vs));
#define DIFF_LOADV(dst, s4_) do { _Pragma("unroll") for (int db = 0; db < 4; ++db) { const s16x4 v0 = tr16(vs + db * 4096 + (s4_) * 1024), v1 = tr16(vs + db * 4096 + (s4_) * 1024 + 512); \
                dst[db] = (bf16x8){v0[0], v0[1], v0[2], v0[3], v1[0], v1[1], v1[2], v1[3]}; } } while (0)
#define DIFF_PV4(src, pf_) do { _Pragma("unroll") for (int db = 0; db < 4; ++db) O[db] = MFMA32(src[db], pf_, O[db]); } while (0)
            f32x16 A[2];
            bf16x8 kf[8], va[4], vb[4];
#pragma unroll
            for (int i = 0; i < 8; ++i) kf[i] = ldsfrag(ks + 2048 * (i & 3) + 512 * (i >> 2));
#pragma unroll
            for (int blk = 0; blk < 2; ++blk) {
                f32x16 s1 = zero16();
#pragma unroll
                for (int s = 0; s < 4; ++s) s1 = MFMA32(kf[4 * blk + s], qf[s], s1);
                A[blk] = s1;
            }
            DIFF_LOADV(va, 0); DIFF_LOADV(vb, 1);
            __builtin_amdgcn_sched_barrier(0);
#pragma unroll
            for (int blk = 0; blk < 2; ++blk)
#pragma unroll
                for (int r = 0; r < 16; ++r) { A[blk][r] = __builtin_amdgcn_exp2f(A[blk][r]); l += A[blk][r]; }
            bf16x8 pf[4];
#pragma unroll
            for (int s4 = 0; s4 < 4; ++s4) pf[s4] = pack8(A[s4 >> 1], 8 * (s4 & 1));
            __builtin_amdgcn_sched_barrier(0);
            DIFF_PV4(va, pf[0]); DIFF_LOADV(va, 2);
            __builtin_amdgcn_sched_barrier(0);
            DIFF_PV4(vb, pf[1]); DIFF_LOADV(vb, 3);
            __builtin_amdgcn_sched_barrier(0);
            DIFF_PV4(va, pf[2]); DIFF_PV4(vb, pf[3]);
#undef DIFF_LOADV
#undef DIFF_PV4
        }
    }
#undef DIFF_DMA
    l += __shfl_xor(l, 32);
    __syncthreads();
    LAS float* comb = (LAS float*)ring + qg * 4096;
    if (mp == 1) {
        const float sc = lam / l;
#pragma unroll
        for (int db = 0; db < 4; ++db)
#pragma unroll
            for (int r = 0; r < 16; ++r) comb[(db * 16 + r) * 64 + lane] = O[db][r] * sc;
    }
    __syncthreads();
    if (mp == 0) {
        const float inv = 1.0f / l;
        float ss = 0.f;
#pragma unroll
        for (int db = 0; db < 4; ++db)
#pragma unroll
            for (int r = 0; r < 16; ++r) { const float o = O[db][r] * inv - comb[(db * 16 + r) * 64 + lane]; O[db][r] = o; ss += o * o; }
        ss += __shfl_xor(ss, 32);
        const float rinv = (1.0f - LAM_INIT) / sqrtf(ss * (1.0f / 128.0f) + NORM_EPS);
        int hh = h; asm volatile("" : "+v"(hh));
        bf16_t* yrow = Y + (size_t)tokq * DM + 512 + hb * 128;
        unsigned char* yb = (unsigned char*)yrow + 16 * hh;
#pragma unroll
        for (int db = 0; db < 4; ++db)
#pragma unroll
            for (int rp = 0; rp < 4; rp += 2) {
                u32x2 w[2];
#pragma unroll
                for (int q = 0; q < 2; ++q) { const int rg = rp + q, d = 32 * db + 8 * rg + 4 * hh;
                    const f32x4 gv = *(const f32x4*)(gsub + d);
                    w[q].x = cvt_pk_bf16(O[db][4 * rg] * rinv * gv[0], O[db][4 * rg + 1] * rinv * gv[1]); w[q].y = cvt_pk_bf16(O[db][4 * rg + 2] * rinv * gv[2], O[db][4 * rg + 3] * rinv * gv[3]); }
                const auto rx = __builtin_amdgcn_permlane32_swap(w[0].x, w[1].x, false, false), ry = __builtin_amdgcn_permlane32_swap(w[0].y, w[1].y, false, false);
                *(u32x4*)(yb + 16 * (4 * db + rp)) = (u32x4){(unsigned)rx[0], (unsigned)ry[0], (unsigned)rx[1], (unsigned)ry[1]};
            }
    }
}

__device__ __forceinline__ void p2_mixers(const Ctx& X, const Params& P, LAS unsigned char* ldsall) {
    const bool xl = (X.nwg & 7) == 0; const int gx = X.nwg >> 3;
    for (int i = 0;; ++i) {
        int u; if (xl) { const int v = X.mk + gx * i; if (v >= 128) break; u = X.mx * 128 + v; } else { u = X.wg + X.nwg * i; if (u >= NBATCH * 32) break; }
        const int b = u >> 5, j = ((u & 31) + (((X.nwg & 31) == 0) ? 8 * i : 0)) & 31;
        dsa_unit(X, P, ldsall, b, j);
        dsa_unit(X, P, ldsall, b, 63 - j);
    }
    float lam;
    { const float a = wave_sum(CF(P.ws, C_LQ1)[X.lane] * CF(P.ws, C_LK1)[X.lane]), bq = wave_sum(CF(P.ws, C_LQ2)[X.lane] * CF(P.ws, C_LK2)[X.lane]); lam = expf(a) - expf(bq) + LAM_INIT; }
    for (int i = 0;; ++i) {
        int u; if (xl) { const int v = X.mk + gx * i; if (v >= 128) break; u = X.mx * 128 + v; } else { u = X.wg + X.nwg * i; if (u >= NBATCH * 4 * 8) break; }
        const int j = u & 7, hb = (u >> 3) & 3, b = u >> 5;
        diff_unit(X, P, ldsall, b, hb, j, lam);
        diff_unit(X, P, ldsall, b, hb, 15 - j, lam);
    }
}

namespace g8 {
typedef float f32x4 __attribute__((ext_vector_type(4)));
constexpr int BM = 256, BK = 64, HALF = 128, HTB = HALF * BK * 2, STAGE_BYTES = 8 * HTB, KDIM = 1024, NT = KDIM / BK;
__device__ __forceinline__ int lds_byte(int r, int c) { const int st = (r >> 4) * 2 + (c >> 5), rr = r & 15, cc = c & 31, ob = rr * 64 + cc * 2; return st * 1024 + (ob ^ (((ob >> 9) & 1) << 5)); }
__device__ __forceinline__ void stage_rc(int b, int& R, int& C) { const int st = b / 1024, sb = b % 1024, swz = sb ^ (((sb >> 9) & 1) << 5); R = (st >> 1) * 16 + swz / 64; C = (st & 1) * 32 + (swz % 64) / 2; }
__device__ __forceinline__ int perm32(int rho) { const int n = rho >> 4, i = rho & 15; return 8 * (i >> 2) + 4 * n + (i & 3); }

struct Unit { int rt, pn, e, row0, nvalid; };

template <class Epi, class Sched, bool GATHER, bool F8 = false>
__device__ __forceinline__ void gemm_phase(LAS unsigned char* lds, LAS unsigned char* ldsidx, const Sched& S, const Epi& E, int wid_) {
    int lane = lane_id(); asm volatile("" : "+v"(lane));
    const int wid = wid_, tid = wid * 64 + lane, wr = wid >> 2, wc = wid & 3, fr = lane & 15, fq = lane >> 4;
    constexpr int RP = F8 ? 1024 : 2048, nt = RP / 128;
    unsigned voffB[2], cu[2][2];
#pragma unroll
    for (int i = 0; i < 2; ++i) { int R, C; stage_rc(tid * 16 + i * 8192, R, C); const int Rb = Epi::PERM ? ((R & ~31) + perm32(R & 31)) : R;
        voffB[i] = (unsigned)(Rb * RP + C * 2);
        cu[0][i] = (unsigned)(R * RP + C * 2); cu[1][i] = (unsigned)((R + HALF) * RP + C * 2); }
    const size_t kstep = (size_t)(BK * 2);
    const size_t hstep = (size_t)HALF * RP;
    const unsigned lbase = (unsigned)__builtin_amdgcn_readfirstlane((int)((unsigned)(uintptr_t)lds + (unsigned)wid * 1024u));
    const int aoff = F8 ? lds_byte(wr * 64 + fr, fq * 16) : lds_byte(wr * 64 + fr, fq * 8), boff = F8 ? lds_byte(wc * 32 + fr, fq * 16) : lds_byte(wc * 32 + fr, fq * 8);
    constexpr int KOFF = F8 ? 16 : 1024;
#define G8_SA(b, h) (((b) * 2 + (h)) * HTB)
#define G8_SB(b, h) ((4 + (b) * 2 + (h)) * HTB)
#define G8_DMA(gbase, voff, ldsoff) do { unsigned sv_; \
        asm volatile("s_mov_b32 %0, m0\n\ts_add_u32 m0, %3, %4\n\ts_nop 0\n\tglobal_load_lds_dwordx4 %1, %2\n\ts_mov_b32 m0, %0" : "=&s"(sv_) : "v"(voff), "s"(gbase), "s"(lbase), "n"(ldsoff) : "memory", "scc"); } while (0)
#define G8_STAGEB(bufoff, gbase) do { G8_DMA((gbase), voffB[0], (bufoff)); G8_DMA((gbase), voffB[1], (bufoff) + 8192); } while (0)
#define G8_STAGEA_(bufoff, gbase, o0, o1) do { G8_DMA((gbase), (o0), (bufoff)); G8_DMA((gbase), (o1), (bufoff) + 8192); } while (0)
#define G8_STAGEA(bufoff, gbase, hh) do { if constexpr (GATHER) { G8_STAGEA_(bufoff, gbase, cu[hh][0], cu[hh][1]); } else { G8_STAGEA_(bufoff, (gbase) + (hh) * hstep, cu[0][0], cu[0][1]); } } while (0)
#define G8_LDA(dst, b, h) do { _Pragma("unroll") for (int m = 0; m < 4; ++m) _Pragma("unroll") for (int k = 0; k < 2; ++k) dst[m][k] = *(const LAS bf16x8*)(lds + G8_SA(b, h) + aoff + m * 2048 + k * KOFF); } while (0)
#define G8_LDB(dst, b, h) do { _Pragma("unroll") for (int n = 0; n < 2; ++n) _Pragma("unroll") for (int k = 0; k < 2; ++k) dst[n][k] = *(const LAS bf16x8*)(lds + G8_SB(b, h) + boff + n * 2048 + k * KOFF); } while (0)
#define G8_MMA(ai, bj, At, Bt) do { __builtin_amdgcn_s_setprio(1); \
        if constexpr (F8) { _Pragma("unroll") for (int m = 0; m < 4; ++m) _Pragma("unroll") for (int n = 0; n < 2; ++n) { \
            const u32x4 b0_ = __builtin_bit_cast(u32x4, Bt[n][0]), b1_ = __builtin_bit_cast(u32x4, Bt[n][1]), a0_ = __builtin_bit_cast(u32x4, At[m][0]), a1_ = __builtin_bit_cast(u32x4, At[m][1]); \
            const v8i32 bw_ = (v8i32){(int)b0_.x, (int)b0_.y, (int)b0_.z, (int)b0_.w, (int)b1_.x, (int)b1_.y, (int)b1_.z, (int)b1_.w}, aw_ = (v8i32){(int)a0_.x, (int)a0_.y, (int)a0_.z, (int)a0_.w, (int)a1_.x, (int)a1_.y, (int)a1_.z, (int)a1_.w}; \
            acc[ai][bj][m][n] = __builtin_amdgcn_mfma_scale_f32_16x16x128_f8f6f4(bw_, aw_, acc[ai][bj][m][n], 0, 0, 0, W8_E8M0, 0, ONE_E8M0); } } \
        else { _Pragma("unroll") for (int m = 0; m < 4; ++m) _Pragma("unroll") for (int n = 0; n < 2; ++n) _Pragma("unroll") for (int k = 0; k < 2; ++k) \
            acc[ai][bj][m][n] = __builtin_amdgcn_mfma_f32_16x16x32_bf16(Bt[n][k], At[m][k], acc[ai][bj][m][n], 0, 0, 0); } \
        __builtin_amdgcn_s_setprio(0); } while (0)
#define G8_WAIT_V(n) asm volatile("s_waitcnt vmcnt(" #n ")" ::: "memory")
#define G8_WAIT_L(n) asm volatile("s_waitcnt lgkmcnt(" #n ")" ::: "memory")
#define G8_BAR __builtin_amdgcn_s_barrier()
#define G8_SCHED __builtin_amdgcn_sched_barrier(0)
    Unit cur, nxt; int ui = 0;
    if (!S.next(0, cur)) return;
    f32x4 acc[2][2][4][2];
    {
        f32x4 nb0[2][2];
        if constexpr (Epi::BIAS) { int t3_ = lane_id(); asm volatile("" : "+v"(t3_)); E.bias(cur, wc, t3_ >> 4, nb0); }
#pragma unroll
        for (int a = 0; a < 2; ++a)
#pragma unroll
            for (int b = 0; b < 2; ++b)
#pragma unroll
                for (int m = 0; m < 4; ++m)
#pragma unroll
                    for (int n = 0; n < 2; ++n) { if constexpr (Epi::BIAS) acc[a][b][m][n] = nb0[b][n]; else acc[a][b][m][n] = (f32x4){0.f, 0.f, 0.f, 0.f}; }
    }
    bf16x8 At[4][2], B0[2][2], B1[2][2];
    const char* cA = S.a_ptr(cur); const char* cB = S.b_ptr(cur);
    if constexpr (GATHER) {
        if (wid < 4) __builtin_amdgcn_global_load_lds((const unsigned*)(S.idx_ptr(cur) + wid * 64 + lane), (LAS unsigned*)(ldsidx + wid * 256), 4, 0, 0);
        G8_WAIT_V(0); G8_BAR;
        const LAS int* ix = (const LAS int*)ldsidx;
#pragma unroll
        for (int i = 0; i < 2; ++i) { int R, C; stage_rc(tid * 16 + i * 8192, R, C); cu[0][i] = (unsigned)(ix[R] * RP + C * 2); cu[1][i] = (unsigned)(ix[HALF + R] * RP + C * 2); }
        G8_WAIT_L(0); G8_BAR;
    }
    G8_STAGEB(G8_SB(0, 0), cB); G8_STAGEB(G8_SB(0, 1), cB + hstep); G8_STAGEA(G8_SA(0, 0), cA, 0); G8_STAGEA(G8_SA(0, 1), cA, 1);
    if (wr == 1) G8_BAR;
    G8_WAIT_V(2); G8_BAR;
    G8_STAGEB(G8_SB(1, 0), cB + kstep); G8_STAGEA(G8_SA(1, 0), cA + kstep, 0); G8_STAGEB(G8_SB(1, 1), cB + hstep + kstep);
    G8_WAIT_V(6); G8_BAR;
    for (;;) {
        const bool has_next = S.next(ui + 1, nxt);
        const char* nA = has_next ? S.a_ptr(nxt) : cA; const char* nB = has_next ? S.b_ptr(nxt) : cB;
        if constexpr (GATHER) {
            if (has_next && wid < 4) __builtin_amdgcn_global_load_lds((const unsigned*)(S.idx_ptr(nxt) + wid * 64 + lane), (LAS unsigned*)(ldsidx + ((ui + 1) & 1) * 1024 + wid * 256), 4, 0, 0);
        }
#pragma unroll 1
        for (int t = 0; t < nt; t += 2) {
            const bool last = (t == nt - 2);
            if constexpr (Epi::PREFETCH) { if (t == 2) E.prefetch(cur, lds + 131072, wid); }
            const char* a1 = cA + (size_t)(t + 1) * kstep;
            const char* a2 = last ? nA : cA + (size_t)(t + 2) * kstep; const char* b2 = last ? nB : cB + (size_t)(t + 2) * kstep;
            const char* a3 = a2 + kstep; const char* b3 = b2 + kstep;
            G8_LDB(B0, 0, 0); G8_LDB(B1, 0, 1); G8_SCHED; G8_LDA(At, 0, 0); G8_STAGEA(G8_SA(1, 1), a1, 1);
            G8_WAIT_V(8); G8_WAIT_L(0); G8_BAR; G8_MMA(0, 0, At, B0); G8_MMA(0, 1, At, B1); G8_BAR; G8_SCHED;
            if constexpr (GATHER) {
                if (last && has_next) { const LAS int* ix = (const LAS int*)(ldsidx + ((ui + 1) & 1) * 1024);
#pragma unroll
                    for (int i = 0; i < 2; ++i) { int R, C; stage_rc(tid * 16 + i * 8192, R, C); cu[0][i] = (unsigned)(ix[R] * RP + C * 2); cu[1][i] = (unsigned)(ix[HALF + R] * RP + C * 2); } }
            }
            G8_LDA(At, 0, 1); G8_STAGEB(G8_SB(0, 0), b2); G8_STAGEB(G8_SB(0, 1), b2 + hstep); G8_STAGEA(G8_SA(0, 0), a2, 0);
            G8_WAIT_V(8); G8_WAIT_L(0); G8_BAR; G8_MMA(1, 0, At, B0); G8_MMA(1, 1, At, B1); G8_BAR; G8_SCHED;
            G8_LDB(B0, 1, 0); G8_LDB(B1, 1, 1); G8_SCHED; G8_LDA(At, 1, 0); G8_STAGEA(G8_SA(0, 1), a2, 1);
            G8_WAIT_V(8); G8_WAIT_L(0); G8_BAR; G8_MMA(0, 0, At, B0); G8_MMA(0, 1, At, B1); G8_BAR; G8_SCHED;
            G8_LDA(At, 1, 1); G8_STAGEB(G8_SB(1, 0), b3); G8_STAGEB(G8_SB(1, 1), b3 + hstep); G8_STAGEA(G8_SA(1, 0), a3, 0);
            G8_WAIT_V(8); G8_WAIT_L(0); G8_BAR; G8_MMA(1, 0, At, B0); G8_MMA(1, 1, At, B1); G8_BAR; G8_SCHED;
        }
        if (wr == 0) G8_BAR;
        f32x4 nb[2][2];
        { int t2_ = lane_id(); asm volatile("" : "+v"(t2_));
          if constexpr (Epi::BIAS) E.bias(has_next ? nxt : cur, wc, t2_ >> 4, nb);
          E(acc, cur, wr, wc, t2_ & 15, t2_ >> 4); }
        if (!has_next) break;
#pragma unroll
        for (int a = 0; a < 2; ++a)
#pragma unroll
            for (int b = 0; b < 2; ++b)
#pragma unroll
                for (int m = 0; m < 4; ++m)
#pragma unroll
                    for (int n = 0; n < 2; ++n) { if constexpr (Epi::BIAS) acc[a][b][m][n] = nb[b][n]; else acc[a][b][m][n] = (f32x4){0.f, 0.f, 0.f, 0.f}; }
        cur = nxt; cA = nA; cB = nB; ++ui;
        if (wr == 1) G8_BAR;
    }
    G8_WAIT_V(0);
    G8_BAR;
#undef G8_SA
#undef G8_SB
#undef G8_STAGEA
#undef G8_STAGEA_
#undef G8_DMA
#undef G8_STAGEB
#undef G8_LDA
#undef G8_LDB
#undef G8_MMA
#undef G8_WAIT_V
#undef G8_WAIT_L
#undef G8_BAR
#undef G8_SCHED
}

struct DenseSched {
    const char* A; const char* B; int t0, t1, npn, x, k, gx;
    __device__ __forceinline__ bool next(int i, Unit& u) const {
        const int j = i * gx + k, q = j / npn, rt = t0 + x + 8 * q;
        if (rt >= t1) return false;
        u.rt = rt; u.pn = j - q * npn; u.e = 0; u.row0 = rt * BM; u.nvalid = BM;
        return true;
    }
    __device__ __forceinline__ const char* a_ptr(const Unit& u) const { return A + (size_t)u.rt * (BM * KDIM * 2); }
    __device__ __forceinline__ const char* b_ptr(const Unit& u) const { return B + (size_t)u.pn * (BM * KDIM * 2); }
    __device__ __forceinline__ const int* idx_ptr(const Unit&) const { return nullptr; }
};
}


struct EpiInProj {
    static constexpr bool PERM = true, PREFETCH = true, BIAS = false;
    unsigned char* ws; LAS unsigned char* xr;
    __device__ __forceinline__ void prefetch(const g8::Unit& u, LAS unsigned char* xbuf, int wid) const {
        const int lane = lane_id();
        const unsigned char* src = ws + WS_ROPE + (size_t)u.rt * (256 * 64);
#pragma unroll
        for (int i = 0; i < 2; ++i) { const int pc = wid + 8 * i, P = pc * 64 + lane, row = P >> 2, uu = P & 3;
            dma16(src + (size_t)(row * 4 + (uu ^ ((row >> 2) & 3))) * 16, xbuf + pc * 1024); }
    }
    template <bool GAIN, bool ROPE, int KMODE>
    __device__ __forceinline__ void body(const g8::f32x4 (&acc)[2][2][4][2], const g8::Unit& u, int wr, int fr, int fq, const float* gain, float scale, bf16_t* dst, int pitch) const {
        g8::f32x4 gv[2][2];
        if constexpr (GAIN) {
#pragma unroll
            for (int bj = 0; bj < 2; ++bj)
#pragma unroll
                for (int n = 0; n < 2; ++n) gv[bj][n] = *(const g8::f32x4*)(gain + 32 * bj + 8 * fq + 4 * n) * scale;
        }
#pragma unroll
        for (int ai = 0; ai < 2; ++ai)
#pragma unroll
            for (int m = 0; m < 4; ++m) {
                const int tok = 256 * u.rt + 128 * ai + 64 * wr + 16 * m + fr;
                g8::f32x4 y[2][2];
                if constexpr (GAIN) {
                    float ss = 0.f;
#pragma unroll
                    for (int bj = 0; bj < 2; ++bj)
#pragma unroll
                        for (int n = 0; n < 2; ++n) { const g8::f32x4 v = acc[ai][bj][m][n]; ss += (v[0] * v[0] + v[1] * v[1]) + (v[2] * v[2] + v[3] * v[3]); }
                    { const auto r_ = __builtin_amdgcn_permlane16_swap(__float_as_uint(ss), __float_as_uint(ss), false, false); ss = __uint_as_float(r_[0]) + __uint_as_float(r_[1]); }
                    { const auto r_ = __builtin_amdgcn_permlane32_swap(__float_as_uint(ss), __float_as_uint(ss), false, false); ss = __uint_as_float(r_[0]) + __uint_as_float(r_[1]); }
                    const float rinv = __builtin_amdgcn_rsqf(ss * (1.0f / 64.0f) + NORM_EPS);
#pragma unroll
                    for (int bj = 0; bj < 2; ++bj)
#pragma unroll
                        for (int n = 0; n < 2; ++n) y[bj][n] = acc[ai][bj][m][n] * rinv * gv[bj][n];
                } else {
#pragma unroll
                    for (int bj = 0; bj < 2; ++bj)
#pragma unroll
                        for (int n = 0; n < 2; ++n) y[bj][n] = acc[ai][bj][m][n];
                }
                if constexpr (ROPE) {
                    const int rowu = 128 * ai + 64 * wr + 16 * m + fr;
                    const LAS unsigned char* rbase = (fq < 2) ? xr + rowu * 64 : xr + 16384; const int sw = (fq < 2) ? (rowu >> 2) & 3 : 0;
                    const int uA = (fq & 1) ? 2 : 0, uB = 2 - uA; const unsigned sgnB = (fq == 0) ? 0x80000000u : 0u;
#pragma unroll
                    for (int n = 0; n < 2; ++n) {
                        const g8::f32x4 A4 = *(const LAS g8::f32x4*)(rbase + 16 * ((uA + n) ^ sw)), B4 = *(const LAS g8::f32x4*)(rbase + 16 * ((uB + n) ^ sw));
#pragma unroll
                        for (int e = 0; e < 4; ++e) {
                            const unsigned xm = __float_as_uint(y[0][n][e]);
                            const auto r_ = __builtin_amdgcn_permlane16_swap(xm, xm, false, false);
                            const float lo_ = __uint_as_float(r_[0]), hi_ = __uint_as_float(r_[1]), bs_ = __uint_as_float(__float_as_uint(B4[e]) ^ sgnB);
                            float t_;
                            asm("v_mul_f32 %0, %1, %2" : "=v"(t_) : "v"(hi_), "v"(bs_));
                            asm("v_fmac_f32 %0, %1, %2" : "+v"(t_) : "v"(lo_), "v"(A4[e]));
                            y[0][n][e] = t_;
                        }
                    }
                }
                const int bb = tok >> 11, ss_ = tok & 2047;
                bf16_t* drow; int bjstep;
                if constexpr (KMODE == 0) { drow = dst + (size_t)tok * pitch + 8 * fq; bjstep = 32; }
                else if constexpr (KMODE == 1) { drow = dst + (size_t)bb * 1048576 + (ss_ >> 6) * 4096 + fq * 512 + (ss_ & 63) * 8; bjstep = 2048; }
                else if constexpr (KMODE == 2) { drow = dst + (size_t)bb * 131072 + (ss_ >> 6) * 4096 + fq * 512 + (ss_ & 63) * 8; bjstep = 2048; }
                else { drow = dst + (size_t)bb * 131072 + (ss_ >> 5) * 2048 + fq * 256 + (ss_ & 31) * 8; bjstep = 1024; }
#pragma unroll
                for (int bj = 0; bj < 2; ++bj) {
                    u32x4 w; w.x = cvt_pk_bf16(y[bj][0][0], y[bj][0][1]); w.y = cvt_pk_bf16(y[bj][0][2], y[bj][0][3]);
                    w.z = cvt_pk_bf16(y[bj][1][0], y[bj][1][1]); w.w = cvt_pk_bf16(y[bj][1][2], y[bj][1][3]);
                    *(u32x4*)(drow + bjstep * bj) = w;
                }
                asm volatile("" ::: "memory");
            }
    }
    __device__ __forceinline__ void operator()(const g8::f32x4 (&acc)[2][2][4][2], const g8::Unit& u, int wr, int wc, int fr, int fq) const {
        asm volatile("" : "+v"(fr), "+v"(fq));
        const int g = 4 * u.pn + wc;
        if (g < 8) body<true, true, 0>(acc, u, wr, fr, fq, CF(ws, C_GQA), QSCALE, (bf16_t*)(ws + WS_QA) + g * 64, 512);
        else if (g < 16) body<false, true, 0>(acc, u, wr, fr, fq, nullptr, 1.0f, (bf16_t*)(ws + WS_QI) + (g - 8) * 64, 512);
        else if (g < 24) body<true, true, 0>(acc, u, wr, fr, fq, CF(ws, C_GQB), QSCALE, (bf16_t*)(ws + WS_QB) + (g - 16) * 64, 512);
        else if (g < 32) body<true, true, 1>(acc, u, wr, fr, fq, CF(ws, C_GKB), 1.0f, (bf16_t*)(ws + WS_KB) + (size_t)(g - 24) * 131072, 0);
        else if (g < 40) body<false, false, 0>(acc, u, wr, fr, fq, nullptr, 1.0f, (bf16_t*)(ws + WS_VBT) + (g - 32) * 64, 512);
        else if (g == 40) body<true, true, 2>(acc, u, wr, fr, fq, CF(ws, C_GKA), 1.0f, (bf16_t*)(ws + WS_KA), 0);
        else if (g == 41) body<false, false, 0>(acc, u, wr, fr, fq, nullptr, 1.0f, (bf16_t*)(ws + WS_VAT), 64);
        else if (g == 42) body<true, true, 3>(acc, u, wr, fr, fq, CF(ws, C_GIK), 1.0f, (bf16_t*)(ws + WS_KI), 0);
        else {
#pragma unroll
            for (int ai = 0; ai < 2; ++ai)
#pragma unroll
                for (int m = 0; m < 4; ++m) {
                    const int tok = 256 * u.rt + 128 * ai + 64 * wr + 16 * m + fr;
                    if (fq == 0) { float* wi = (float*)(ws + WS_WI) + (size_t)tok * 8; *(g8::f32x4*)wi = acc[ai][0][m][0] * IW_SCALE; *(g8::f32x4*)(wi + 4) = acc[ai][0][m][1] * IW_SCALE; }
                }
        }
    }
};
__device__ __forceinline__ void p1_inproj_g8(const Ctx& X, const Params& P, LAS unsigned char* ldsall) {
    g8::DenseSched S; S.A = (const char*)(P.ws + WS_H); S.B = (const char*)(P.ws + WS_WIN); S.t0 = 0; S.t1 = T_TOK / 256; S.npn = NGROUP / 4; S.x = X.mx; S.k = X.mk; S.gx = X.nwg >> 3;
    if (X.tid < 16) ((LAS float*)(ldsall + 4096 + 131072 + 16384))[X.tid] = X.tid < 8 ? 1.0f : 0.0f;
    __syncthreads();
    EpiInProj E{P.ws, ldsall + 4096 + 131072};
    g8::gemm_phase<EpiInProj, g8::DenseSched, false>(ldsall + 4096, ldsall + 2048, S, E, X.wid);
}

struct EpiOutProj {
    static constexpr bool PERM = true, PREFETCH = false, BIAS = false;
    const float* x; bf16_t* x1b;
    __device__ __forceinline__ void operator()(const g8::f32x4 (&acc)[2][2][4][2], const g8::Unit& u, int wr, int wc, int fr, int fq) const {
        asm volatile("" : "+v"(fr), "+v"(fq));
        const int row0 = u.rt * 256 + wr * 64 + fr, col0 = u.pn * 256 + wc * 32 + 8 * fq;
#pragma unroll
        for (int ai = 0; ai < 2; ++ai)
#pragma unroll
            for (int m = 0; m < 4; ++m) {
                const size_t ro = (size_t)(row0 + ai * 128 + m * 16) * DM + col0;
#pragma unroll
                for (int bj = 0; bj < 2; ++bj) {
                    const g8::f32x4 v0 = *(const g8::f32x4*)(x + ro + bj * 128) + acc[ai][bj][m][0], v1 = *(const g8::f32x4*)(x + ro + bj * 128 + 4) + acc[ai][bj][m][1];
                    u32x4 w; w.x = cvt_pk_bf16(v0[0], v0[1]); w.y = cvt_pk_bf16(v0[2], v0[3]); w.z = cvt_pk_bf16(v1[0], v1[1]); w.w = cvt_pk_bf16(v1[2], v1[3]);
                    *(u32x4*)(x1b + ro + bj * 128) = w;
                }
            }
    }
};
__device__ __forceinline__ void p3_outproj_g8(const Ctx& X, const Params& P, LAS unsigned char* ldsall) {
    g8::DenseSched S; S.A = (const char*)(P.ws + WS_H); S.B = (const char*)(P.ws + WS_WO); S.t0 = 0; S.t1 = T_TOK / 256; S.npn = 4; S.x = X.mx; S.k = X.mk; S.gx = X.nwg >> 3;
    EpiOutProj E{P.in[0], (bf16_t*)(P.ws + WS_X1B)};
    g8::gemm_phase<EpiOutProj, g8::DenseSched, false>(ldsall + 4096, ldsall + 2048, S, E, X.wid);
}

__device__ __forceinline__ void p4_router(const Ctx& X, const Params& P) {
    unsigned char* ws = P.ws;
    const bf16_t* x1b = (const bf16_t*)(ws + WS_X1B); const float* g = CF(ws, C_GFFN);
    const bf16_t* WR = (const bf16_t*)(ws + WS_WR);
    const float* brt = CF(ws, C_BRT);
    int* topk_e = (int*)(ws + WS_TOPK_E); float* topk_g = (float*)(ws + WS_TOPK_G); int* CNT = (int*)(ws + WS_CNT);
    const int c = X.c, h = X.h, lane = X.lane;
    LAS int* hist = (LAS int*)X.lds;
    for (int wgt = X.wg; wgt < T_TOK / 256; wgt += X.nwg) {
        if (X.tid < 32) hist[X.tid] = 0;
        __syncthreads();
        const int tok0 = wgt * 256 + X.wid * 32;
        f32x4 gv4[4];
#pragma unroll
        for (int i = 0; i < 2; ++i) { gv4[2 * i] = ((const f32x4*)g)[2 * (lane + 64 * i)]; gv4[2 * i + 1] = ((const f32x4*)g)[2 * (lane + 64 * i) + 1]; }
        float myrinv = 0.f;
        for (int r0 = 0; r0 < 32; r0 += 8) {
            u32x4 raw[8][2]; float ss[8];
#pragma unroll
            for (int r = 0; r < 8; ++r)
#pragma unroll
                for (int i = 0; i < 2; ++i) raw[r][i] = *((const u32x4*)(x1b + (size_t)(tok0 + r0 + r) * DM) + lane + 64 * i);
#pragma unroll
            for (int r = 0; r < 8; ++r) { float a = 0.f;
#pragma unroll
                for (int i = 0; i < 2; ++i)
#pragma unroll
                    for (int q = 0; q < 4; ++q) { const float lo = bf_lo(raw[r][i][q]), hi = bf_hi(raw[r][i][q]); a += lo * lo + hi * hi; }
                ss[r] = a; }
#pragma unroll
            for (int o = 32; o >= 1; o >>= 1)
#pragma unroll
                for (int r = 0; r < 8; ++r) ss[r] += __shfl_xor(ss[r], o);
#pragma unroll
            for (int r = 0; r < 8; ++r) {
                const int row = tok0 + r0 + r;
                const float rinv = 1.0f / sqrtf(ss[r] * (1.0f / DM) + NORM_EPS);
                if (c == r0 + r) myrinv = rinv;
#pragma unroll
                for (int i = 0; i < 2; ++i) {
                    float y[8];
#pragma unroll
                    for (int q = 0; q < 4; ++q) { y[2 * q] = bf_lo(raw[r][i][q]) * rinv * gv4[2 * i + (q >> 1)][2 * (q & 1)]; y[2 * q + 1] = bf_hi(raw[r][i][q]) * rinv * gv4[2 * i + (q >> 1)][2 * (q & 1) + 1]; }
                    u32x2 w; w.x = cvt4_fp8(y[0], y[1], y[2], y[3]); w.y = cvt4_fp8(y[4], y[5], y[6], y[7]);
                    *(u32x2*)(ws + WS_H2F8 + (size_t)row * DM + 8 * (lane + 64 * i)) = w;
                }
            }
        }
        f32x16 L = zero16();
        {
            const bf16_t* ap = WR + (size_t)c * DM + 8 * h;
            const bf16_t* bp = x1b + (size_t)(tok0 + c) * DM + 8 * h;
#pragma unroll 4
            for (int k0 = 0; k0 < DM; k0 += 16) {
                const u32x4 raw = *(const u32x4*)(bp + k0);
                L = MFMA32(ldfrag(ap + k0), __builtin_bit_cast(bf16x8, raw), L);
            }
        }
#pragma unroll
        for (int r = 0; r < 16; ++r) L[r] *= myrinv;
        float own[16], oth[16];
#pragma unroll
        for (int r = 0; r < 16; ++r) { own[r] = L[r] + brt[crow(r, h)]; }
#pragma unroll
        for (int r = 0; r < 16; ++r) oth[r] = __shfl_xor(own[r], 32);
        float tv[4]; int te[4];
#pragma unroll
        for (int k = 0; k < 4; ++k) {
            float best = -INFINITY; int bid = 1 << 20;
#pragma unroll
            for (int r = 0; r < 16; ++r) {
                const int e0 = crow(r, h), e1 = crow(r, 1 - h);
                if (own[r] > best || (own[r] == best && e0 < bid)) { best = own[r]; bid = e0; }
                if (oth[r] > best || (oth[r] == best && e1 < bid)) { best = oth[r]; bid = e1; }
            }
            tv[k] = best; te[k] = min(max(bid, 0), 31);
#pragma unroll
            for (int r = 0; r < 16; ++r) { if (crow(r, h) == bid) own[r] = -INFINITY; if (crow(r, 1 - h) == bid) oth[r] = -INFINITY; }
        }
        if (h == 0) {
            const float e0 = 1.0f, e1 = expf(tv[1] - tv[0]), e2 = expf(tv[2] - tv[0]), e3 = expf(tv[3] - tv[0]);
            const float inv = 1.0f / (e0 + e1 + e2 + e3);
            const int tok = tok0 + c;
            *(int4*)(topk_e + (size_t)tok * 4) = make_int4(te[0], te[1], te[2], te[3]);
            f32x4 gg; gg[0] = e0 * inv; gg[1] = e1 * inv; gg[2] = e2 * inv; gg[3] = e3 * inv;
            *(f32x4*)(topk_g + (size_t)tok * 4) = gg;
#pragma unroll
            for (int k = 0; k < 4; ++k) atomicAdd((int*)&hist[te[k]], 1);
        }
        __syncthreads();
        if (X.tid < 32) CNT[wgt * 32 + X.tid] = hist[X.tid];
        __syncthreads();
    }
}

__device__ __forceinline__ void p5_slots(const Ctx& X, const Params& P) {
    unsigned char* ws = P.ws;
    const int* CNT = (const int*)(ws + WS_CNT); int* EXPS = (int*)(ws + WS_EXP);
    const int* topk_e = (const int*)(ws + WS_TOPK_E); int* tokslot = (int*)(ws + WS_TOKSLOT); int* slottok = (int*)(ws + WS_SLOTTOK);
    LAS int* tot = (LAS int*)X.lds;
    LAS int* base = (LAS int*)X.lds + 32;
    LAS int* start = (LAS int*)X.lds + 64;
    LAS int* cur = (LAS int*)X.lds + 128;
    for (int wgt = X.wg; wgt < T_TOK / 256; wgt += X.nwg) {
        __syncthreads();
        {
            LAS int* ptot = (LAS int*)X.lds + 256; LAS int* pbase = (LAS int*)X.lds + 768;
            const int e = X.tid & 31, part = X.tid >> 5;
            int t = 0, bs = 0;
#pragma unroll
            for (int i = 0; i < 16; ++i) { const int w = part * 16 + i; const int v = CNT[w * 32 + e]; t += v; bs += (w < wgt) ? v : 0; }
            ptot[part * 32 + e] = t; pbase[part * 32 + e] = bs;
            __syncthreads();
            if (X.tid < 32) { int tt = 0, bb = 0;
#pragma unroll
                for (int q = 0; q < 16; ++q) { tt += ptot[q * 32 + X.tid]; bb += pbase[q * 32 + X.tid]; }
                tot[X.tid] = tt; base[X.tid] = bb; cur[X.tid] = 0; }
        }
        __syncthreads();
        if (X.tid == 0) { int s = 0; for (int e = 0; e < 32; ++e) { start[e] = s; s += tot[e]; } start[32] = s; }
        __syncthreads();
        if (wgt == 0) {
            if (X.tid < 33) EXPS[X.tid] = start[X.tid];
            if (X.tid < 256) slottok[NSLOT + X.tid] = 0;
        }
        if (X.tid < 256) {
            const int tok = wgt * 256 + X.tid;
            const int4 e4 = *(const int4*)(topk_e + (size_t)tok * 4);
            const int es[4] = {e4.x, e4.y, e4.z, e4.w};
            int sl[4];
#pragma unroll
            for (int k = 0; k < 4; ++k) { const int e = min(max(es[k], 0), 31); const int pos = atomicAdd((int*)&cur[e], 1); sl[k] = min(max(start[e] + base[e] + pos, 0), NSLOT - 1); slottok[sl[k]] = tok; }
            *(int4*)(tokslot + (size_t)tok * 4) = make_int4(sl[0], sl[1], sl[2], sl[3]);
        }
    }
}

constexpr size_t WS_ACT = MIB(208);
template <bool GATHER, int NPN, int PITCH, int BROWS>
struct MoeSched {
    const LAS int* desc;
    const char* A; const char* B; const int* slottok; int t1, x, k, gx;
    __device__ __forceinline__ bool next(int i, g8::Unit& u) const {
        const int j = i * gx + k, q = j / NPN, rt = x + 8 * q;
        if (rt >= t1) return false;
        const int row0 = __builtin_amdgcn_readfirstlane(desc[2 * rt]), info = __builtin_amdgcn_readfirstlane(desc[2 * rt + 1]);
        u.rt = rt; u.pn = j - q * NPN; u.e = info >> 16; u.row0 = row0; u.nvalid = info & 0xffff;
        return true;
    }
    __device__ __forceinline__ const char* a_ptr(const g8::Unit& u) const { return GATHER ? A : A + (size_t)u.row0 * PITCH; }
    __device__ __forceinline__ const char* b_ptr(const g8::Unit& u) const { return B + ((size_t)u.e * BROWS + (size_t)u.pn * 256) * PITCH; }
    __device__ __forceinline__ const int* idx_ptr(const g8::Unit& u) const { return slottok + u.row0; }
};
struct EpiGU {
    static constexpr bool PERM = true, PREFETCH = false, BIAS = true;
    const float* bgu; unsigned char* act; int rb;
    __device__ __forceinline__ void bias(const g8::Unit& u, int wc, int fq, g8::f32x4 (&nb)[2][2]) const {
        const int colbase = 128 * u.pn + 32 * wc + 8 * fq;
#pragma unroll
        for (int n = 0; n < 2; ++n) { nb[0][n] = *(const g8::f32x4*)(bgu + (size_t)u.e * 2048 + colbase + 4 * n); nb[1][n] = *(const g8::f32x4*)(bgu + (size_t)u.e * 2048 + 1024 + colbase + 4 * n) + 1.0f; }
    }
    __device__ __forceinline__ void operator()(const g8::f32x4 (&acc)[2][2][4][2], const g8::Unit& u, int wr, int wc, int fr, int fq) const {
        asm volatile("" : "+v"(fr), "+v"(fq));
        const int colst = 128 * u.pn + 32 * wc + 8 * (fq & ~1);
#pragma unroll
        for (int ai = 0; ai < 2; ++ai)
#pragma unroll
            for (int mp = 0; mp < 4; mp += 2) {
                u32x2 w[2];
#pragma unroll
                for (int q2 = 0; q2 < 2; ++q2) {
                    const int m = mp + q2;
                    float a[8];
                    typedef float f32x2e __attribute__((ext_vector_type(2)));
#pragma unroll
                    for (int n = 0; n < 2; ++n)
#pragma unroll
                        for (int q = 0; q < 4; q += 2) {
                            f32x2e g2 = (f32x2e){acc[ai][0][m][n][q], acc[ai][0][m][n][q + 1]};
                            g2[0] = __builtin_amdgcn_fmed3f(g2[0], -3.0e38f, 7.0f); g2[1] = __builtin_amdgcn_fmed3f(g2[1], -3.0e38f, 7.0f);
                            f32x2e l2 = (f32x2e){acc[ai][1][m][n][q], acc[ai][1][m][n][q + 1]};
                            l2[0] = __builtin_amdgcn_fmed3f(l2[0], -6.0f, 8.0f); l2[1] = __builtin_amdgcn_fmed3f(l2[1], -6.0f, 8.0f);
                            const f32x2e t2 = g2 * -2.4554669595930157f;
                            f32x2e d2 = (f32x2e){__builtin_amdgcn_exp2f(t2[0]), __builtin_amdgcn_exp2f(t2[1])} + 1.0f;
                            const f32x2e s2 = (f32x2e){__builtin_amdgcn_rcpf(d2[0]), __builtin_amdgcn_rcpf(d2[1])};
                            const f32x2e a2 = g2 * s2 * l2;
                            a[4 * n + q] = a2[0]; a[4 * n + q + 1] = a2[1];
                        }
                    w[q2].x = cvt4_fp8(a[0], a[1], a[2], a[3]); w[q2].y = cvt4_fp8(a[4], a[5], a[6], a[7]);
                }
                const auto rx = __builtin_amdgcn_permlane16_swap(w[0].x, w[1].x, false, false), ry = __builtin_amdgcn_permlane16_swap(w[0].y, w[1].y, false, false);
                const int r = 128 * ai + 64 * wr + 16 * (mp + (fq & 1)) + fr;
                if (r < u.nvalid) *(u32x4*)(act + (size_t)(u.row0 - rb + r) * DEXP + colst) = (u32x4){(unsigned)rx[0], (unsigned)ry[0], (unsigned)rx[1], (unsigned)ry[1]};
                asm volatile("" ::: "memory");
            }
    }
};
struct EpiDown {
    static constexpr bool PERM = true, PREFETCH = false, BIAS = true;
    const float* bdn; unsigned char* ys;
    __device__ __forceinline__ void bias(const g8::Unit& u, int wc, int fq, g8::f32x4 (&nb)[2][2]) const {
        const int colbase = 256 * u.pn + 32 * wc + 8 * fq;
#pragma unroll
        for (int bj = 0; bj < 2; ++bj)
#pragma unroll
            for (int n = 0; n < 2; ++n) nb[bj][n] = *(const g8::f32x4*)(bdn + (size_t)u.e * 1024 + colbase + 128 * bj + 4 * n);
    }
    __device__ __forceinline__ void operator()(const g8::f32x4 (&acc)[2][2][4][2], const g8::Unit& u, int wr, int wc, int fr, int fq) const {
        asm volatile("" : "+v"(fr), "+v"(fq));
        const int colst = 256 * u.pn + 32 * wc + 8 * (fq & ~1);
#pragma unroll
        for (int bj = 0; bj < 2; ++bj) {
#pragma unroll
            for (int ai = 0; ai < 2; ++ai)
#pragma unroll
                for (int mp = 0; mp < 4; mp += 2) {
                    u32x2 w[2];
#pragma unroll
                    for (int q2 = 0; q2 < 2; ++q2) { const g8::f32x4 v0 = acc[ai][bj][mp + q2][0], v1 = acc[ai][bj][mp + q2][1];
                        w[q2].x = cvt4_fp8(v0[0], v0[1], v0[2], v0[3]); w[q2].y = cvt4_fp8(v1[0], v1[1], v1[2], v1[3]); }
                    const auto rx = __builtin_amdgcn_permlane16_swap(w[0].x, w[1].x, false, false), ry = __builtin_amdgcn_permlane16_swap(w[0].y, w[1].y, false, false);
                    const int r = 128 * ai + 64 * wr + 16 * (mp + (fq & 1)) + fr;
                    if (r < u.nvalid) *(u32x4*)(ys + (size_t)(u.row0 + r) * DM + colst + 128 * bj) = (u32x4){(unsigned)rx[0], (unsigned)ry[0], (unsigned)rx[1], (unsigned)ry[1]};
                }
            asm volatile("" ::: "memory");
        }
    }
};
constexpr int LDS_TDESC = 4096 + 131072;
#define P6_ROUNDS(X, P, ldsall, bar) do { \
    unsigned char* ws_ = (P).ws; \
    LAS int* es_ = (LAS int*)((ldsall) + 64); LAS int* tp_ = (LAS int*)((ldsall) + 256); LAS int* desc_ = (LAS int*)((ldsall) + LDS_TDESC); \
    __syncthreads(); \
    if ((X).tid < 33) es_[(X).tid] = min(max(((const int*)(ws_ + WS_EXP))[(X).tid], 0), NSLOT); \
    __syncthreads(); \
    if ((X).tid == 0) { int s_ = 0; for (int e_ = 0; e_ < 32; ++e_) { tp_[e_] = s_; s_ += max(es_[e_ + 1] - es_[e_] + 255, 0) >> 8; } tp_[32] = s_; } \
    __syncthreads(); \
    const int ntile_ = min(tp_[32], 1056); \
    for (int t_ = (X).tid; t_ < ntile_; t_ += 512) { int e_ = 0; for (int kk_ = 1; kk_ < 32; ++kk_) if (tp_[kk_] <= t_) e_ = kk_; \
        const int row0_ = es_[e_] + 256 * (t_ - tp_[e_]); desc_[2 * t_] = row0_; desc_[2 * t_ + 1] = (e_ << 16) | min(256, es_[e_ + 1] - row0_); } \
    __syncthreads(); \
    { \
        { MoeSched<true, 8, 1024, 2048> S_; S_.desc = desc_; S_.slottok = (const int*)(ws_ + WS_SLOTTOK); S_.t1 = ntile_; S_.x = (X).mx; S_.k = (X).mk; S_.gx = (X).nwg >> 3; \
          S_.A = (const char*)(ws_ + WS_H2F8); S_.B = (const char*)(ws_ + WS_WGU); \
          EpiGU E_{CF(ws_, C_BGU), ws_ + WS_ACT, 0}; g8::gemm_phase<EpiGU, MoeSched<true, 8, 1024, 2048>, true, true>((ldsall) + 4096, (ldsall) + 2048, S_, E_, (X).wid); } \
        xcd_barrier(bar); \
        { MoeSched<false, 4, 1024, 1024> S_; S_.desc = desc_; S_.slottok = nullptr; S_.t1 = ntile_; S_.x = (X).mx; S_.k = (X).mk; S_.gx = (X).nwg >> 3; \
          S_.A = (const char*)(ws_ + WS_ACT); S_.B = (const char*)(ws_ + WS_WD); \
          EpiDown E_{CF(ws_, C_BDN), ws_ + WS_YS}; g8::gemm_phase<EpiDown, MoeSched<false, 4, 1024, 1024>, false, true>((ldsall) + 4096, (ldsall) + 2048, S_, E_, (X).wid); } \
        xcd_barrier(bar); \
    } } while (0)

__device__ __forceinline__ void p7_combine(const Ctx& X, const Params& P) {
    unsigned char* ws = P.ws;
    const int* tokslot = (const int*)(ws + WS_TOKSLOT); const float* topk_g = (const float*)(ws + WS_TOPK_G); const unsigned char* YS = ws + WS_YS;
    float* out = P.out; const bf16_t* x1b = (const bf16_t*)(ws + WS_X1B);
    typedef float f32x2v __attribute__((ext_vector_type(2)));
    for (int tok = X.gw; tok < T_TOK; tok += X.nw) {
        const int4 sl = *(const int4*)(tokslot + (size_t)tok * 4); const f32x4 gg = *(const f32x4*)(topk_g + (size_t)tok * 4);
        const int s4[4] = {min(max(sl.x, 0), NSLOT - 1), min(max(sl.y, 0), NSLOT - 1), min(max(sl.z, 0), NSLOT - 1), min(max(sl.w, 0), NSLOT - 1)};
#pragma unroll
        for (int half = 0; half < 2; ++half) {
            const int col = half * 512 + X.lane * 8;
            const u32x4 xw = __builtin_nontemporal_load((const u32x4*)(x1b + (size_t)tok * DM + col));
            f32x4 o0, o1; o0[0] = bf_lo(xw.x); o0[1] = bf_hi(xw.x); o0[2] = bf_lo(xw.y); o0[3] = bf_hi(xw.y); o1[0] = bf_lo(xw.z); o1[1] = bf_hi(xw.z); o1[2] = bf_lo(xw.w); o1[3] = bf_hi(xw.w);
#pragma unroll
            for (int k = 0; k < 4; ++k) {
                const u32x2 y = __builtin_nontemporal_load((const u32x2*)(YS + (size_t)s4[k] * DM + col)); const float gk = gg[k];
                const f32x2v a = __builtin_amdgcn_cvt_pk_f32_fp8((int)y.x, false), b = __builtin_amdgcn_cvt_pk_f32_fp8((int)y.x, true);
                const f32x2v c = __builtin_amdgcn_cvt_pk_f32_fp8((int)y.y, false), d = __builtin_amdgcn_cvt_pk_f32_fp8((int)y.y, true);
                o0[0] += gk * a[0]; o0[1] += gk * a[1]; o0[2] += gk * b[0]; o0[3] += gk * b[1];
                o1[0] += gk * c[0]; o1[1] += gk * c[1]; o1[2] += gk * d[0]; o1[3] += gk * d[1];
            }
            __builtin_nontemporal_store(o0, (f32x4*)(out + (size_t)tok * DM + col)); __builtin_nontemporal_store(o1, (f32x4*)(out + (size_t)tok * DM + col + 4));
        }
    }
}

constexpr int LDS_BYTES = 155648;
__global__ void __launch_bounds__(512, 2) fwd(Params P) {
    extern __shared__ __attribute__((aligned(16))) unsigned char lds[];
    const int wid0_ = __builtin_amdgcn_readfirstlane((int)threadIdx.x >> 6);
    if (threadIdx.x == 0) *(LAS u32x4*)lds = (u32x4){0u, 0u, 0u, 0u};
    __syncthreads();
    (void)xcd_barrier_post((unsigned*)(P.ws + WS_BAR), (volatile LAS unsigned*)lds, threadIdx.x == 0);
    if (threadIdx.x == 0) { const unsigned xc = xb_xcc_id(); ((LAS unsigned*)lds)[4] = xc; ((LAS unsigned*)lds)[5] = xb_add((unsigned*)(P.ws + WS_XRANK) + 64 * xc, 1u); }
#define xcd_barrier(b) xcd_barrier_((b), wid0_ == 0 && lane_id() == 0)
#define bar (XcdBarrier{(unsigned*)(P.ws + WS_BAR), xb_xcc_id(), (volatile LAS unsigned*)lds})
    Ctx X;
#define NEW_CTX() do { int l_ = lane_id(); asm volatile("" : "+v"(l_));     \
    X.lane = l_; X.wid = wid0_; X.tid = wid0_ * 64 + l_; X.c = X.lane & 31; X.h = X.lane >> 5; \
    X.wg = blockIdx.x; X.nwg = gridDim.x; X.gw = X.wg * 8 + X.wid; X.nw = X.nwg * 8; X.lds = (LAS unsigned char*)lds + 64; \
    { const LAS unsigned* m_ = (const LAS unsigned*)lds; const bool hw_ = (m_[2] != 0u) && (m_[4] < 8u) && (m_[5] < m_[0]);     \
      X.mx = __builtin_amdgcn_readfirstlane(hw_ ? (int)m_[4] : (X.wg & 7)); X.mk = __builtin_amdgcn_readfirstlane(hw_ ? (int)m_[5] : (X.wg >> 3)); } } while (0)

    NEW_CTX();
    p0_prologue(X, P);
    xcd_barrier(bar);
    NEW_CTX();
    p1_inproj_g8(X, P, (LAS unsigned char*)lds);
    xcd_barrier(bar);
    NEW_CTX();
    p2_mixers(X, P, (LAS unsigned char*)lds);
    xcd_barrier(bar);
    NEW_CTX();
    p3_outproj_g8(X, P, (LAS unsigned char*)lds);
    xcd_barrier(bar);
    NEW_CTX();
    p4_router(X, P);
    xcd_barrier(bar);
    NEW_CTX();
    p5_slots(X, P);
    xcd_barrier(bar);
    NEW_CTX();
    P6_ROUNDS(X, P, (LAS unsigned char*)lds, bar);
    NEW_CTX();
    p7_combine(X, P);
}

extern "C" void kernel_launch(void* const* d_in, const int* in_sizes, int n_in, void* d_out, int out_size, void* d_ws, size_t ws_size, hipStream_t stream) {
    static int grid = 0;
    if (grid == 0) {
        if (n_in != 22 || out_size != T_TOK * DM || ws_size < WS_END) { fprintf(stderr, "kernel_launch: unexpected shapes (n_in %d out %d ws %zu)\n", n_in, out_size, ws_size); grid = -1; return; }
        int dev = 0, cus = 0, per_cu = 0;
        if (hipGetDevice(&dev) != hipSuccess || hipDeviceGetAttribute(&cus, hipDeviceAttributeMultiprocessorCount, dev) != hipSuccess) { grid = -1; return; }
        if (hipFuncSetAttribute((const void*)fwd, hipFuncAttributeMaxDynamicSharedMemorySize, LDS_BYTES) != hipSuccess) { fprintf(stderr, "kernel_launch: hipFuncSetAttribute failed\n"); grid = -1; return; }
        if (hipOccupancyMaxActiveBlocksPerMultiprocessor(&per_cu, (const void*)fwd, 512, LDS_BYTES) != hipSuccess || per_cu < 1) { fprintf(stderr, "kernel_launch: occupancy query says %d\n", per_cu); }
        (void)hipGetLastError();
        grid = cus;
    }
    if (grid < 0) return;
    (void)hipMemsetAsync(d_ws, 0, 24576, stream);
    Params p{};
    for (int i = 0; i < 22; ++i) p.in[i] = (const float*)d_in[i];
    p.out = (float*)d_out; p.ws = (unsigned char*)d_ws;
    hipLaunchKernelGGL(fwd, dim3(grid), dim3(512), LDS_BYTES, stream, p);
}
```
